# Optimizing an MI355X kernel written in HIP

```python
import math
import jax, jax.numpy as jnp
from jax import lax
import numpy as np

D_MODEL = 1024
BATCH = 8
SEQ = 4096
DEPTH = 1

N_META = 16
GRID_W = 64
Q_BLOCK = 128
HEAD_DIM = 64
ROPE_THETA = 10000.0
EPS = 1e-6
A_HEADS = 8
A_KV_HEADS = 2
A_GROUP = A_HEADS // A_KV_HEADS
A_WIDTH = A_HEADS * HEAD_DIM
A_KV_WIDTH = A_KV_HEADS * HEAD_DIM
B_HEADS = 4
B_VDIM = 2 * HEAD_DIM
B_WIDTH = B_HEADS * B_VDIM
MIX_WIDTH = A_WIDTH + B_WIDTH
IN_WIDTH = A_WIDTH + 2 * A_KV_WIDTH + 3 * B_WIDTH
D_FF = -(-8 * D_MODEL // (3 * 256)) * 256

kernel_name = "hymba_axial_gqa_diffattn_swiglu"


def rms_norm(x, g):
    xf = x.astype(jnp.float32)
    y = xf * lax.rsqrt(jnp.mean(xf * xf, axis=-1, keepdims=True) + EPS)
    return (y * g.astype(jnp.float32)).astype(x.dtype)


def apply_rope(x, ang):
    xf = x.astype(jnp.float32).reshape(x.shape[:-1] + (x.shape[-1] // 2, 2))
    c = jnp.cos(ang)[None, :, None, :]
    s = jnp.sin(ang)[None, :, None, :]
    x1, x2 = xf[..., 0], xf[..., 1]
    out = jnp.stack([x1 * c - x2 * s, x1 * s + x2 * c], axis=-1)
    return out.reshape(x.shape).astype(x.dtype)


def rope_angles_1d(length):
    pos = jnp.arange(length, dtype=jnp.float32)
    inv = ROPE_THETA ** (-jnp.arange(0, HEAD_DIM, 2, dtype=jnp.float32) / HEAD_DIM)
    return pos[:, None] * inv[None, :]


def rope_angles_axial(n_tokens):
    rows = n_tokens // GRID_W
    r = jnp.repeat(jnp.arange(rows, dtype=jnp.float32), GRID_W)
    c = jnp.tile(jnp.arange(GRID_W, dtype=jnp.float32), rows)
    half = HEAD_DIM // 2
    inv = ROPE_THETA ** (-jnp.arange(0, half, 2, dtype=jnp.float32) / half)
    ang = jnp.concatenate([r[:, None] * inv[None, :], c[:, None] * inv[None, :]], axis=-1)
    meta = jnp.zeros((N_META, HEAD_DIM // 2), jnp.float32)
    return jnp.concatenate([meta, ang], axis=0)


def sweep_queries(fn, q):
    out_meta = fn(q[:, :N_META])
    real = q[:, N_META:]
    bsz, s = real.shape[0], real.shape[1]
    nb = s // Q_BLOCK
    blocks = jnp.moveaxis(real.reshape((bsz, nb, Q_BLOCK) + real.shape[2:]), 1, 0)
    out = lax.map(fn, blocks)
    out = jnp.moveaxis(out, 0, 1).reshape((bsz, s) + out.shape[3:])
    return jnp.concatenate([out_meta, out], axis=1)


def setup_inputs(seed: int = 0) -> dict:
    key = jax.random.key(seed)
    ks = jax.random.split(key, 20)
    f32 = jnp.float32

    def gain(k, shape):
        return 1.0 + 0.1 * jax.random.normal(k, shape, f32)

    return {
        "x": jax.random.normal(ks[0], (BATCH, SEQ, D_MODEL), f32),
        "meta_tokens": jax.random.normal(ks[1], (N_META, D_MODEL), f32),
        "attn_norm_g": gain(ks[2], (DEPTH, D_MODEL)),
        "w_in": jax.random.normal(ks[3], (DEPTH, D_MODEL, IN_WIDTH), f32) * D_MODEL ** -0.5,
        "a_q_norm_g": gain(ks[4], (DEPTH, HEAD_DIM)),
        "a_k_norm_g": gain(ks[5], (DEPTH, HEAD_DIM)),
        "b_q_norm_g": gain(ks[6], (DEPTH, HEAD_DIM)),
        "b_k_norm_g": gain(ks[7], (DEPTH, HEAD_DIM)),
        "b_lambda_q1": 0.1 * jax.random.normal(ks[8], (DEPTH, HEAD_DIM), f32),
        "b_lambda_k1": 0.1 * jax.random.normal(ks[9], (DEPTH, HEAD_DIM), f32),
        "b_lambda_q2": 0.1 * jax.random.normal(ks[10], (DEPTH, HEAD_DIM), f32),
        "b_lambda_k2": 0.1 * jax.random.normal(ks[11], (DEPTH, HEAD_DIM), f32),
        "b_subln_g": gain(ks[12], (DEPTH, B_VDIM)),
        "w_out": jax.random.normal(ks[13], (DEPTH, MIX_WIDTH, D_MODEL), f32) * MIX_WIDTH ** -0.5,
        "ffn_norm_g": gain(ks[14], (DEPTH, D_MODEL)),
        "w_gate": jax.random.normal(ks[15], (DEPTH, D_MODEL, D_FF), f32) * D_MODEL ** -0.5,
        "w_up": jax.random.normal(ks[16], (DEPTH, D_MODEL, D_FF), f32) * D_MODEL ** -0.5,
        "w_down": jax.random.normal(ks[17], (DEPTH, D_FF, D_MODEL), f32) * D_FF ** -0.5,
    }


def reference(x, meta_tokens, attn_norm_g, w_in, a_q_norm_g, a_k_norm_g, b_q_norm_g, b_k_norm_g,
              b_lambda_q1, b_lambda_k1, b_lambda_q2, b_lambda_k2, b_subln_g, w_out,
              ffn_norm_g, w_gate, w_up, w_down):
    bsz, s, _ = x.shape
    meta = jnp.broadcast_to(meta_tokens.astype(x.dtype)[None], (bsz, N_META, D_MODEL))
    x = jnp.concatenate([meta, x], axis=1)
    length = N_META + s

    ang_a = rope_angles_axial(s)
    ang_b = rope_angles_1d(length)
    scale = HEAD_DIM ** -0.5
    splits = np.cumsum([A_WIDTH, A_KV_WIDTH, A_KV_WIDTH, B_WIDTH, B_WIDTH]).tolist()

    for l in range(DEPTH):
        lam_init = 0.8 - 0.6 * math.exp(-0.3 * l)
        h = rms_norm(x, attn_norm_g[l])
        proj = jnp.einsum('bld,de->ble', h, w_in[l])
        qa, ka, va, qb, kb, vb = jnp.split(proj, splits, axis=-1)

        qa = apply_rope(rms_norm(qa.reshape(bsz, length, A_HEADS, HEAD_DIM), a_q_norm_g[l]), ang_a)
        ka = apply_rope(rms_norm(ka.reshape(bsz, length, A_KV_HEADS, HEAD_DIM), a_k_norm_g[l]), ang_a)
        va = va.reshape(bsz, length, A_KV_HEADS, HEAD_DIM)

        def gqa_block(q):
            nq = q.shape[1]
            qg = q.reshape(q.shape[0], nq, A_KV_HEADS, A_GROUP, HEAD_DIM)
            sc = jnp.einsum('bqkgd,blkd->bkgql', qg, ka).astype(jnp.float32) * scale
            p = jax.nn.softmax(sc, axis=-1).astype(va.dtype)
            o = jnp.einsum('bkgql,blkd->bqkgd', p, va)
            return o.reshape(q.shape[0], nq, A_WIDTH)

        out_a = sweep_queries(gqa_block, qa)

        qb = apply_rope(rms_norm(qb.reshape(bsz, length, 2 * B_HEADS, HEAD_DIM), b_q_norm_g[l]), ang_b)
        kb = apply_rope(rms_norm(kb.reshape(bsz, length, 2 * B_HEADS, HEAD_DIM), b_k_norm_g[l]), ang_b)
        qb = qb.reshape(bsz, length, B_HEADS, 2, HEAD_DIM)
        kb = kb.reshape(bsz, length, B_HEADS, 2, HEAD_DIM)
        vb = vb.reshape(bsz, length, B_HEADS, B_VDIM)
        lam = (jnp.exp(jnp.sum(b_lambda_q1[l].astype(jnp.float32) * b_lambda_k1[l].astype(jnp.float32)))
               - jnp.exp(jnp.sum(b_lambda_q2[l].astype(jnp.float32) * b_lambda_k2[l].astype(jnp.float32)))
               + lam_init)
        subln_g = b_subln_g[l]

        def diff_block(q):
            nq = q.shape[1]
            sc = jnp.einsum('bqhjd,blhjd->bhjql', q, kb).astype(jnp.float32) * scale
            p = jax.nn.softmax(sc, axis=-1)
            w = (p[:, :, 0] - lam * p[:, :, 1]).astype(vb.dtype)
            o = jnp.einsum('bhql,blhe->bqhe', w, vb)
            o = rms_norm(o, subln_g) * (1.0 - lam_init)
            return o.reshape(q.shape[0], nq, B_WIDTH)

        out_b = sweep_queries(diff_block, qb)

        mixed = jnp.concatenate([out_a, out_b], axis=-1)
        x = x + jnp.einsum('ble,ed->bld', mixed, w_out[l])

        h = rms_norm(x, ffn_norm_g[l])
        g = jnp.einsum('bld,df->blf', h, w_gate[l])
        u = jnp.einsum('bld,df->blf', h, w_up[l])
        x = x + jnp.einsum('blf,fd->bld', jax.nn.silu(g) * u, w_down[l])

    return x[:, N_META:]
```

```cpp
#include <hip/hip_runtime.h>
#include <cstdint>
#include <cstdio>
#include <cmath>

typedef unsigned short bf16_t;
namespace cfg {
constexpr int NB = 8, SEQ = 4096, NMETA = 16, DM = 1024, NTOK = NB * SEQ;
constexpr int INW = 2304, DFF = 2816, NT_KV = 65;
constexpr float EPS = 1e-6f, LOG2E = 1.4426950408889634f, C2 = 0.125f * LOG2E;
constexpr float LAM_INIT = 0.2f;
constexpr size_t MiB = 1u << 20;
constexpr size_t WS_CTL = 0, WS_RS = 1 * MiB, WS_SS = 1 * MiB + 256 * 1024;
constexpr size_t WS_XB = 32 * MiB;
constexpr size_t WS_QA = WS_XB + 33024ull * 2048;
constexpr size_t WS_QB = WS_QA + 32 * MiB;
constexpr size_t WS_KA = WS_QB + 32 * MiB;
constexpr size_t WS_VA = WS_KA + 16ull * NT_KV * 8192;
constexpr size_t WS_KB = WS_VA + 16ull * NT_KV * 8192;
constexpr size_t WS_VB = WS_KB + 64ull * NT_KV * 8192;
constexpr size_t WS_REND = WS_VB + 32ull * NT_KV * 16384;
constexpr size_t WS_HID = 32 * MiB;
constexpr size_t WS_MIX = 242 * MiB, WS_X1B = 306 * MiB, WS_STASH = 370 * MiB, WS_NAIVE = 306 * MiB, WS_PROJF = 242 * MiB, WS_END = 512 * MiB;
static_assert(WS_REND <= WS_MIX && WS_HID + 32768ull * DFF * 2 <= WS_MIX, "ws map");
}
using namespace cfg;

__host__ __device__ __forceinline__ unsigned f2bf(float f) { unsigned u = __builtin_bit_cast(unsigned, f); return (u + 0x7fffu + ((u >> 16) & 1u)) >> 16; }
__host__ __device__ __forceinline__ float bf2f(bf16_t h) { return __builtin_bit_cast(float, (unsigned)h << 16); }
__host__ __device__ __forceinline__ size_t kidx(int grp, int krow, int d) { return ((size_t)grp * NT_KV + (krow >> 6)) * 4096 + (d >> 3) * 512 + (krow & 63) * 8 + (d & 7); }
__host__ __device__ __forceinline__ size_t vidx(int grp, int krow, int d, int ndb) { return ((size_t)grp * NT_KV + (krow >> 6)) * (size_t)(ndb * 2048) + (d >> 5) * 2048 + (krow & 63) * 32 + (d & 31); }

struct RopeInv { float a[16]; float b[32]; };
__device__ __forceinline__ void rope_cs(float ang, float& c, float& s) {
    double rev = (double)ang * 0.15915494309189535; rev -= floor(rev); const float r = (float)rev;
    c = __builtin_amdgcn_cosf(r); s = __builtin_amdgcn_sinf(r);
}

__global__ void __launch_bounds__(256) nk_rowss(const float* x, const float* meta, float* ss, int nrows) {
    const int row = blockIdx.x * 4 + (threadIdx.x >> 6), lane = threadIdx.x & 63;
    if (row >= nrows) return;
    const float* p = row < NTOK ? x + (size_t)row * DM : meta + (size_t)(row - NTOK) * DM;
    float s = 0.f;
    for (int i = lane; i < DM; i += 64) { const float v = p[i]; s += v * v; }
    for (int o = 1; o < 64; o <<= 1) s += __shfl_xor(s, o);
    if (lane == 0) ss[row] = s;
}

template <int NW, class AL, class WL, class EP>
__global__ void __launch_bounds__(256) nk_gemm(int M, int N, int K, AL al, WL wl, EP ep) {
    __shared__ float As[16][68];
    __shared__ float Ws[NW][16][68];
    const int tid = threadIdx.x, tx = tid & 15, ty = tid >> 4, m0 = blockIdx.y * 64, n0 = blockIdx.x * 64;
    float acc[NW][4][4];
#pragma unroll
    for (int w = 0; w < NW; ++w)
#pragma unroll
        for (int i = 0; i < 4; ++i)
#pragma unroll
            for (int j = 0; j < 4; ++j) acc[w][i][j] = 0.f;
    for (int k0 = 0; k0 < K; k0 += 16) {
#pragma unroll
        for (int i = 0; i < 4; ++i) { const int e = tid + i * 256, r = e >> 4, kk = e & 15, row = m0 + r; As[kk][r] = row < M ? al(row, k0 + kk) : 0.f; }
#pragma unroll
        for (int w = 0; w < NW; ++w)
#pragma unroll
            for (int i = 0; i < 4; ++i) { const int e = tid + i * 256, kk = e >> 6, c = e & 63; Ws[w][kk][c] = wl(w, k0 + kk, n0 + c); }
        __syncthreads();
#pragma unroll
        for (int kk = 0; kk < 16; ++kk) {
            float a[4];
#pragma unroll
            for (int i = 0; i < 4; ++i) a[i] = As[kk][ty * 4 + i];
#pragma unroll
            for (int w = 0; w < NW; ++w) {
                float b[4];
#pragma unroll
                for (int j = 0; j < 4; ++j) b[j] = Ws[w][kk][tx * 4 + j];
#pragma unroll
                for (int i = 0; i < 4; ++i)
#pragma unroll
                    for (int j = 0; j < 4; ++j) acc[w][i][j] += a[i] * b[j];
            }
        }
        __syncthreads();
    }
#pragma unroll
    for (int i = 0; i < 4; ++i)
#pragma unroll
        for (int j = 0; j < 4; ++j) { const int row = m0 + ty * 4 + i, col = n0 + tx * 4 + j; if (row < M) ep(row, col, acc[0][i][j], NW > 1 ? acc[NW - 1][i][j] : 0.f); }
}

struct AL1 { const float* x; const float* meta; const float* ss; const float* g; __device__ float operator()(int row, int k) const {
    const float v = row < NTOK ? x[(size_t)row * DM + k] : meta[(size_t)(row - NTOK) * DM + k]; return v * rsqrtf(ss[row] * (1.f / DM) + EPS) * g[k]; } };
struct WL1 { const float* w; int coloff; int pad; __device__ float operator()(int, int k, int col) const { return w[(size_t)k * INW + coloff + col]; } };
struct EP1 { float* o; __device__ void operator()(int row, int col, float v, float) const { o[(size_t)row * 1152 + col] = v; } };

__global__ void __launch_bounds__(256) nk_epi1(const float* projf, int slot0, RopeInv inv, const float* gqa, const float* gka, const float* gqb, const float* gkb,
                                               bf16_t* QA, bf16_t* KA, bf16_t* VA, bf16_t* QB, bf16_t* KB, bf16_t* VB) {
    const int idx = blockIdx.x * 256 + threadIdx.x; const int row = idx / 18, sl = idx % 18, slot = slot0 + sl;
    if (row >= NTOK + NMETA) return;
    const bool meta = row >= NTOK; const int m = row - NTOK, b = row / SEQ, t = row % SEQ;
    const float* v = projf + (size_t)row * 1152 + sl * 64;
    int type, hh;
    if (slot < 8) { type = 0; hh = slot; } else if (slot < 10) { type = 1; hh = slot - 8; } else if (slot < 12) { type = 2; hh = slot - 10; }
    else if (slot < 20) { type = 3; hh = slot - 12; } else if (slot < 28) { type = 4; hh = slot - 20; } else { type = 5; hh = slot - 28; }
    if (meta && (type == 0 || type == 3)) return;
    const bool isB = type >= 3, normed = (type != 2 && type != 5);
    const float* g = type == 0 ? gqa : type == 1 ? gka : type == 3 ? gqb : gkb;
    float rn = 1.f;
    if (normed) { float ss = 0.f; for (int d = 0; d < 64; ++d) ss += v[d] * v[d]; rn = rsqrtf(ss * (1.f / 64.f) + EPS); }
    for (int i = 0; i < 32; ++i) {
        float x1 = v[2 * i], x2 = v[2 * i + 1];
        if (normed) {
            x1 *= rn * g[2 * i]; x2 *= rn * g[2 * i + 1];
            float ang;
            if (!isB) ang = meta ? 0.f : (i < 16 ? (float)(t >> 6) * inv.a[i] : (float)(t & 63) * inv.a[i - 16]);
            else ang = (float)(meta ? m : NMETA + t) * inv.b[i];
            float c, s; rope_cs(ang, c, s);
            const float y1 = x1 * c - x2 * s, y2 = x1 * s + x2 * c; x1 = y1; x2 = y2;
            if (type == 0 || type == 3) { x1 *= C2; x2 *= C2; }
        }
        const bf16_t o1 = (bf16_t)f2bf(x1), o2 = (bf16_t)f2bf(x2); const int d = 2 * i;
        const int krow = meta ? m : 64 + t;
        for (int bb = (meta ? 0 : b); bb < (meta ? NB : b + 1); ++bb) {
            if (type == 0) { bf16_t* p = QA + ((size_t)(bb * 8 + hh) * SEQ + t) * 64 + d; p[0] = o1; p[1] = o2; }
            else if (type == 3) { bf16_t* p = QB + ((size_t)(bb * 8 + hh) * SEQ + t) * 64 + d; p[0] = o1; p[1] = o2; }
            else if (type == 1) { KA[kidx(bb * 2 + hh, krow, d)] = o1; KA[kidx(bb * 2 + hh, krow, d + 1)] = o2; }
            else if (type == 4) { KB[kidx(bb * 8 + hh, krow, d)] = o1; KB[kidx(bb * 8 + hh, krow, d + 1)] = o2; }
            else if (type == 2) { VA[vidx(bb * 2 + hh, krow, d, 2)] = o1; VA[vidx(bb * 2 + hh, krow, d + 1, 2)] = o2; }
            else { const int hb = hh >> 1, dd = (hh & 1) * 64 + d; VB[vidx(bb * 4 + hb, krow, dd, 4)] = o1; VB[vidx(bb * 4 + hb, krow, dd + 1, 4)] = o2; }
        }
    }
}

__global__ void __launch_bounds__(256) nk_zero_pads(bf16_t* KA, bf16_t* VA, bf16_t* KB, bf16_t* VB) {
    const int idx = blockIdx.x * 256 + threadIdx.x;
    const int d = idx & 127, kr = 16 + ((idx >> 7) % 48), g = idx / (128 * 48);
    if (g < 16) { if (d < 64) { KA[kidx(g, kr, d)] = 0; VA[vidx(g, kr, d, 2)] = 0; } }
    else if (g < 16 + 64) { if (d < 64) KB[kidx(g - 16, kr, d)] = 0; }
    else if (g < 16 + 64 + 32) VB[vidx(g - 80, kr, d, 4)] = 0;
}

__global__ void __launch_bounds__(256) nk_attn(const bf16_t* Q, const bf16_t* K, const bf16_t* V, float* O, const float* gq, const float* gk, int mode) {
    __shared__ float Ks[64][64];
    __shared__ float Vs[64][64];
    const int tid = threadIdx.x, u = blockIdx.y, q = blockIdx.x * 256 + tid;
    int qu, kgrp, vgrp, ndb, dboff;
    if (mode == 0) { const int b = u >> 3, h = u & 7; qu = u; kgrp = b * 2 + (h >> 2); vgrp = kgrp; ndb = 2; dboff = 0; }
    else { const int dh = u & 1, bs = u >> 1, b = bs >> 3, sh = bs & 7; qu = bs; kgrp = bs; vgrp = b * 4 + (sh >> 1); ndb = 4; dboff = 64 * dh; }
    float mq = 0.f, mk = 0.f;
    for (int d = 0; d < 64; ++d) { mq = fmaxf(mq, fabsf(gq[d])); mk = fmaxf(mk, fabsf(gk[d])); }
    const float Mc = 8.f * mq * mk * LOG2E;
    float qv[64], o[64]; float l = 0.f;
    const bf16_t* qp = Q + ((size_t)qu * SEQ + q) * 64;
#pragma unroll
    for (int d = 0; d < 64; ++d) { qv[d] = bf2f(qp[d]); o[d] = 0.f; }
    for (int tile = 0; tile < NT_KV; ++tile) {
        for (int i = 0; i < 16; ++i) { const int e = tid * 16 + i, key = e >> 6, d = e & 63;
            Ks[key][d] = bf2f(K[kidx(kgrp, tile * 64 + key, d)]); Vs[key][d] = bf2f(V[vidx(vgrp, tile * 64 + key, dboff + d, ndb)]); }
        __syncthreads();
        const int nk = tile == 0 ? NMETA : 64;
        for (int key = 0; key < nk; ++key) {
            float s = -Mc;
#pragma unroll
            for (int d = 0; d < 64; ++d) s += qv[d] * Ks[key][d];
            const float p = exp2f(s); l += p;
#pragma unroll
            for (int d = 0; d < 64; ++d) o[d] += p * Vs[key][d];
        }
        __syncthreads();
    }
    const float il = 1.f / l; float* op = O + ((size_t)u * SEQ + q) * 64;
#pragma unroll
    for (int d = 0; d < 64; ++d) op[d] = o[d] * il;
}

__global__ void __launch_bounds__(256) nk_mix(const float* OA, const float* OB, bf16_t* MIX, const float* lq1, const float* lk1, const float* lq2, const float* lk2, const float* subg) {
    const int idx = blockIdx.x * 256 + threadIdx.x; const int row = idx / 12, part = idx % 12;
    if (row >= NTOK) return;
    const int b = row / SEQ, t = row % SEQ;
    if (part < 8) { const float* s = OA + ((size_t)(b * 8 + part) * SEQ + t) * 64; bf16_t* d = MIX + (size_t)row * DM + part * 64; for (int i = 0; i < 64; ++i) d[i] = (bf16_t)f2bf(s[i]); return; }
    const int hb = part - 8;
    float s1 = 0.f, s2 = 0.f; for (int i = 0; i < 64; ++i) { s1 += lq1[i] * lk1[i]; s2 += lq2[i] * lk2[i]; }
    const float lam = expf(s1) - expf(s2) + LAM_INIT;
    const float* o0 = OB + ((size_t)((b * 8 + 2 * hb) * 2) * SEQ) * 64;
    const float* o1 = OB + ((size_t)((b * 8 + 2 * hb + 1) * 2) * SEQ) * 64;
    float ss = 0.f;
    for (int d = 0; d < 128; ++d) { const size_t off = ((size_t)(d >> 6) * SEQ + t) * 64 + (d & 63); const float v = o0[off] - lam * o1[off]; ss += v * v; }
    const float rn = rsqrtf(ss * (1.f / 128.f) + EPS) * (1.f - LAM_INIT);
    bf16_t* dst = MIX + (size_t)row * DM + 512 + hb * 128;
    for (int d = 0; d < 128; ++d) { const size_t off = ((size_t)(d >> 6) * SEQ + t) * 64 + (d & 63); const float v = o0[off] - lam * o1[off]; dst[d] = (bf16_t)f2bf(v * rn * subg[d]); }
}

struct AL3 { const bf16_t* a; int lda; int pad; __device__ float operator()(int row, int k) const { return bf2f(a[(size_t)row * lda + k]); } };
struct WLp { const float* w; int ldw; int pad; __device__ float operator()(int, int k, int col) const { return w[(size_t)k * ldw + col]; } };
struct EP3 { const float* x; float* x1; bf16_t* x1b; __device__ void operator()(int row, int col, float v, float) const { const size_t o = (size_t)row * DM + col; const float r = x[o] + v; x1[o] = r; x1b[o] = (bf16_t)f2bf(r); } };
struct AL4 { const float* x1; const float* ss; const float* g; __device__ float operator()(int row, int k) const { return x1[(size_t)row * DM + k] * rsqrtf(ss[row] * (1.f / DM) + EPS) * g[k]; } };
struct WL4 { const float* wg; const float* wu; __device__ float operator()(int w, int k, int col) const { return (w ? wu : wg)[(size_t)k * DFF + col]; } };
struct EP4 { bf16_t* hid; __device__ void operator()(int row, int col, float g, float u) const { const float s = g / (1.f + __expf(-g)); hid[(size_t)row * DFF + col] = (bf16_t)f2bf(s * u); } };
struct EP5 { float* out; __device__ void operator()(int row, int col, float v, float) const { out[(size_t)row * DM + col] += v; } };

extern "C" void kernel_launch(void* const* d_in, const int* in_sizes, int n_in, void* d_out, int out_size, void* d_ws, size_t ws_size, hipStream_t stream) {
    const float* x = (const float*)d_in[0]; const float* meta = (const float*)d_in[1]; const float* g1 = (const float*)d_in[2]; const float* w_in = (const float*)d_in[3];
    const float* gqa = (const float*)d_in[4]; const float* gka = (const float*)d_in[5]; const float* gqb = (const float*)d_in[6]; const float* gkb = (const float*)d_in[7];
    const float* lq1 = (const float*)d_in[8]; const float* lk1 = (const float*)d_in[9]; const float* lq2 = (const float*)d_in[10]; const float* lk2 = (const float*)d_in[11];
    const float* subg = (const float*)d_in[12]; const float* w_out = (const float*)d_in[13]; const float* g2 = (const float*)d_in[14];
    const float* w_gate = (const float*)d_in[15]; const float* w_up = (const float*)d_in[16]; const float* w_down = (const float*)d_in[17];
    float* out = (float*)d_out; unsigned char* ws = (unsigned char*)d_ws;
    if (ws_size < WS_END) { fprintf(stderr, "ws too small: %zu\n", ws_size); return; }
    float* rs = (float*)(ws + WS_RS); float* ss2 = (float*)(ws + WS_SS);
    bf16_t *QA = (bf16_t*)(ws + WS_QA), *QB = (bf16_t*)(ws + WS_QB), *KA = (bf16_t*)(ws + WS_KA), *VA = (bf16_t*)(ws + WS_VA), *KB = (bf16_t*)(ws + WS_KB), *VB = (bf16_t*)(ws + WS_VB);
    bf16_t *MIX = (bf16_t*)(ws + WS_MIX), *X1B = (bf16_t*)(ws + WS_X1B), *HID = (bf16_t*)(ws + WS_HID);
    float* projf = (float*)(ws + WS_PROJF); float* OA = (float*)(ws + WS_NAIVE); float* OB = OA + (size_t)64 * SEQ * 64;
    RopeInv inv;
    for (int i = 0; i < 16; ++i) inv.a[i] = (float)pow(10000.0, -(double)(2 * i) / 32.0);
    for (int i = 0; i < 32; ++i) inv.b[i] = (float)pow(10000.0, -(double)(2 * i) / 64.0);
    const int NR = NTOK + NMETA;
    nk_rowss<<<(NR + 3) / 4, 256, 0, stream>>>(x, meta, rs, NR);
    nk_zero_pads<<<(112 * 48 * 128) / 256, 256, 0, stream>>>(KA, VA, KB, VB);
    for (int half = 0; half < 2; ++half) {
        nk_gemm<1, AL1, WL1, EP1><<<dim3(18, (NR + 63) / 64), 256, 0, stream>>>(NR, 1152, DM, AL1{x, meta, rs, g1}, WL1{w_in, half * 1152}, EP1{projf});
        nk_epi1<<<(NR * 18 + 255) / 256, 256, 0, stream>>>(projf, half * 18, inv, gqa, gka, gqb, gkb, QA, KA, VA, QB, KB, VB);
    }
    nk_attn<<<dim3(16, 64), 256, 0, stream>>>(QA, KA, VA, OA, gqa, gka, 0);
    nk_attn<<<dim3(16, 128), 256, 0, stream>>>(QB, KB, VB, OB, gqb, gkb, 1);
    nk_mix<<<(NTOK * 12 + 255) / 256, 256, 0, stream>>>(OA, OB, MIX, lq1, lk1, lq2, lk2, subg);
    nk_gemm<1, AL3, WLp, EP3><<<dim3(16, NTOK / 64), 256, 0, stream>>>(NTOK, DM, DM, AL3{MIX, DM}, WLp{w_out, DM}, EP3{x, out, X1B});
    nk_rowss<<<NTOK / 4, 256, 0, stream>>>(out, nullptr, ss2, NTOK);
    nk_gemm<2, AL4, WL4, EP4><<<dim3(DFF / 64, NTOK / 64), 256, 0, stream>>>(NTOK, DFF, DM, AL4{out, ss2, g2}, WL4{w_gate, w_up}, EP4{HID});
    nk_gemm<1, AL3, WLp, EP5><<<dim3(16, NTOK / 64), 256, 0, stream>>>(NTOK, DM, DFF, AL3{HID, DFF}, WLp{w_down, DM}, EP5{out});
}
```

```cpp
#include <hip/hip_runtime.h>
#include <cstdint>
#include <cstdio>
#include <cmath>

typedef unsigned short bf16_t;
namespace cfg {
constexpr int NB = 8, SEQ = 4096, NMETA = 16, DM = 1024, NTOK = NB * SEQ;
constexpr int INW = 2304, DFF = 2816, NT_KV = 65;
constexpr float EPS = 1e-6f, LOG2E = 1.4426950408889634f, C2 = 0.125f * LOG2E;
constexpr float LAM_INIT = 0.2f;
constexpr size_t MiB = 1u << 20;
constexpr size_t WS_CTL = 0, WS_RS = 1 * MiB, WS_SS = 1 * MiB + 256 * 1024;
constexpr size_t WS_GT = 1 * MiB + 448 * 1024;
constexpr size_t WS_TA = 2 * MiB, WS_TB = 4 * MiB, WS_BT1 = 6 * MiB, WS_BT3 = 11 * MiB, WS_BT4 = 13 * MiB, WS_BT5 = 24 * MiB;
constexpr size_t WS_XB = 32 * MiB;
constexpr size_t WS_QA = WS_XB + 33024ull * 2048;
constexpr size_t WS_QB = WS_QA + 32 * MiB;
constexpr size_t WS_KA = WS_QB + 32 * MiB;
constexpr size_t WS_VA = WS_KA + 16ull * NT_KV * 8192;
constexpr size_t WS_KB = WS_VA + 16ull * NT_KV * 8192;
constexpr size_t WS_VB = WS_KB + 64ull * NT_KV * 8192;
constexpr size_t WS_REND = WS_VB + 32ull * NT_KV * 16384;
constexpr size_t WS_HID = 32 * MiB;
constexpr size_t WS_MIX = 242 * MiB, WS_X1B = 306 * MiB, WS_STASH = 370 * MiB, WS_NAIVE = 306 * MiB, WS_PROJF = 242 * MiB, WS_END = 512 * MiB;
static_assert(WS_REND <= WS_MIX && WS_HID + 32768ull * DFF * 2 <= WS_MIX, "ws map");
}
using namespace cfg;

__host__ __device__ __forceinline__ unsigned f2bf(float f) { unsigned u = __builtin_bit_cast(unsigned, f); return (u + 0x7fffu + ((u >> 16) & 1u)) >> 16; }
__host__ __device__ __forceinline__ float bf2f(bf16_t h) { return __builtin_bit_cast(float, (unsigned)h << 16); }
__host__ __device__ __forceinline__ size_t kidx(int grp, int krow, int d) { return ((size_t)grp * NT_KV + (krow >> 6)) * 4096 + (d >> 3) * 512 + (krow & 63) * 8 + (d & 7); }
__host__ __device__ __forceinline__ size_t vidx(int grp, int krow, int d, int ndb) { return ((size_t)grp * NT_KV + (krow >> 6)) * (size_t)(ndb * 2048) + (d >> 5) * 2048 + (krow & 63) * 32 + (d & 31); }

struct RopeInv { float a[16]; float b[32]; };
__device__ __forceinline__ void rope_cs(float ang, float& c, float& s) {
    double rev = (double)ang * 0.15915494309189535; rev -= floor(rev); const float r = (float)rev;
    c = __builtin_amdgcn_cosf(r); s = __builtin_amdgcn_sinf(r);
}

__global__ void __launch_bounds__(256) nk_rowss(const float* x, const float* meta, float* ss, int nrows) {
    const int row = blockIdx.x * 4 + (threadIdx.x >> 6), lane = threadIdx.x & 63;
    if (row >= nrows) return;
    const float* p = row < NTOK ? x + (size_t)row * DM : meta + (size_t)(row - NTOK) * DM;
    float s = 0.f;
    for (int i = lane; i < DM; i += 64) { const float v = p[i]; s += v * v; }
    for (int o = 1; o < 64; o <<= 1) s += __shfl_xor(s, o);
    if (lane == 0) ss[row] = s;
}

template <int NW, class AL, class WL, class EP>
__global__ void __launch_bounds__(256) nk_gemm(int M, int N, int K, AL al, WL wl, EP ep) {
    __shared__ float As[16][68];
    __shared__ float Ws[NW][16][68];
    const int tid = threadIdx.x, tx = tid & 15, ty = tid >> 4, m0 = blockIdx.y * 64, n0 = blockIdx.x * 64;
    float acc[NW][4][4];
#pragma unroll
    for (int w = 0; w < NW; ++w)
#pragma unroll
        for (int i = 0; i < 4; ++i)
#pragma unroll
            for (int j = 0; j < 4; ++j) acc[w][i][j] = 0.f;
    for (int k0 = 0; k0 < K; k0 += 16) {
#pragma unroll
        for (int i = 0; i < 4; ++i) { const int e = tid + i * 256, r = e >> 4, kk = e & 15, row = m0 + r; As[kk][r] = row < M ? al(row, k0 + kk) : 0.f; }
#pragma unroll
        for (int w = 0; w < NW; ++w)
#pragma unroll
            for (int i = 0; i < 4; ++i) { const int e = tid + i * 256, kk = e >> 6, c = e & 63; Ws[w][kk][c] = wl(w, k0 + kk, n0 + c); }
        __syncthreads();
#pragma unroll
        for (int kk = 0; kk < 16; ++kk) {
            float a[4];
#pragma unroll
            for (int i = 0; i < 4; ++i) a[i] = As[kk][ty * 4 + i];
#pragma unroll
            for (int w = 0; w < NW; ++w) {
                float b[4];
#pragma unroll
                for (int j = 0; j < 4; ++j) b[j] = Ws[w][kk][tx * 4 + j];
#pragma unroll
                for (int i = 0; i < 4; ++i)
#pragma unroll
                    for (int j = 0; j < 4; ++j) acc[w][i][j] += a[i] * b[j];
            }
        }
        __syncthreads();
    }
#pragma unroll
    for (int i = 0; i < 4; ++i)
#pragma unroll
        for (int j = 0; j < 4; ++j) { const int row = m0 + ty * 4 + i, col = n0 + tx * 4 + j; if (row < M) ep(row, col, acc[0][i][j], NW > 1 ? acc[NW - 1][i][j] : 0.f); }
}

struct AL1 { const float* x; const float* meta; const float* ss; const float* g; __device__ float operator()(int row, int k) const {
    const float v = row < NTOK ? x[(size_t)row * DM + k] : meta[(size_t)(row - NTOK) * DM + k]; return v * rsqrtf(ss[row] * (1.f / DM) + EPS) * g[k]; } };
struct WL1 { const float* w; int coloff; int pad; __device__ float operator()(int, int k, int col) const { return w[(size_t)k * INW + coloff + col]; } };
struct EP1 { float* o; __device__ void operator()(int row, int col, float v, float) const { o[(size_t)row * 1152 + col] = v; } };

__global__ void __launch_bounds__(256) nk_epi1(const float* projf, int slot0, RopeInv inv, const float* gqa, const float* gka, const float* gqb, const float* gkb,
                                               bf16_t* QA, bf16_t* KA, bf16_t* VA, bf16_t* QB, bf16_t* KB, bf16_t* VB) {
    const int idx = blockIdx.x * 256 + threadIdx.x; const int row = idx / 18, sl = idx % 18, slot = slot0 + sl;
    if (row >= NTOK + NMETA) return;
    const bool meta = row >= NTOK; const int m = row - NTOK, b = row / SEQ, t = row % SEQ;
    const float* v = projf + (size_t)row * 1152 + sl * 64;
    int type, hh;
    if (slot < 8) { type = 0; hh = slot; } else if (slot < 10) { type = 1; hh = slot - 8; } else if (slot < 12) { type = 2; hh = slot - 10; }
    else if (slot < 20) { type = 3; hh = slot - 12; } else if (slot < 28) { type = 4; hh = slot - 20; } else { type = 5; hh = slot - 28; }
    if (meta && (type == 0 || type == 3)) return;
    const bool isB = type >= 3, normed = (type != 2 && type != 5);
    const float* g = type == 0 ? gqa : type == 1 ? gka : type == 3 ? gqb : gkb;
    float rn = 1.f;
    if (normed) { float ss = 0.f; for (int d = 0; d < 64; ++d) ss += v[d] * v[d]; rn = rsqrtf(ss * (1.f / 64.f) + EPS); }
    for (int i = 0; i < 32; ++i) {
        float x1 = v[2 * i], x2 = v[2 * i + 1];
        if (normed) {
            x1 *= rn * g[2 * i]; x2 *= rn * g[2 * i + 1];
            float ang;
            if (!isB) ang = meta ? 0.f : (i < 16 ? (float)(t >> 6) * inv.a[i] : (float)(t & 63) * inv.a[i - 16]);
            else ang = (float)(meta ? m : NMETA + t) * inv.b[i];
            float c, s; rope_cs(ang, c, s);
            const float y1 = x1 * c - x2 * s, y2 = x1 * s + x2 * c; x1 = y1; x2 = y2;
            if (type == 0 || type == 3) { x1 *= C2; x2 *= C2; }
        }
        const bf16_t o1 = (bf16_t)f2bf(x1), o2 = (bf16_t)f2bf(x2); const int d = 2 * i;
        const int krow = meta ? m : 64 + t;
        for (int bb = (meta ? 0 : b); bb < (meta ? NB : b + 1); ++bb) {
            if (type == 0) { bf16_t* p = QA + ((size_t)(bb * 8 + hh) * SEQ + t) * 64 + d; p[0] = o1; p[1] = o2; }
            else if (type == 3) { bf16_t* p = QB + ((size_t)(bb * 8 + hh) * SEQ + t) * 64 + d; p[0] = o1; p[1] = o2; }
            else if (type == 1) { KA[kidx(bb * 2 + hh, krow, d)] = o1; KA[kidx(bb * 2 + hh, krow, d + 1)] = o2; }
            else if (type == 4) { KB[kidx(bb * 8 + hh, krow, d)] = o1; KB[kidx(bb * 8 + hh, krow, d + 1)] = o2; }
            else if (type == 2) { VA[vidx(bb * 2 + hh, krow, d, 2)] = o1; VA[vidx(bb * 2 + hh, krow, d + 1, 2)] = o2; }
            else { const int hb = hh >> 1, dd = (hh & 1) * 64 + d; VB[vidx(bb * 4 + hb, krow, dd, 4)] = o1; VB[vidx(bb * 4 + hb, krow, dd + 1, 4)] = o2; }
        }
    }
}

__global__ void __launch_bounds__(256) nk_zero_pads(bf16_t* KA, bf16_t* VA, bf16_t* KB, bf16_t* VB) {
    const int idx = blockIdx.x * 256 + threadIdx.x;
    const int d = idx & 127, kr = 16 + ((idx >> 7) % 48), g = idx / (128 * 48);
    if (g < 16) { if (d < 64) { KA[kidx(g, kr, d)] = 0; VA[vidx(g, kr, d, 2)] = 0; } }
    else if (g < 16 + 64) { if (d < 64) KB[kidx(g - 16, kr, d)] = 0; }
    else if (g < 16 + 64 + 32) VB[vidx(g - 80, kr, d, 4)] = 0;
}

__global__ void __launch_bounds__(256) nk_attn(const bf16_t* Q, const bf16_t* K, const bf16_t* V, float* O, const float* gq, const float* gk, int mode) {
    __shared__ float Ks[64][64];
    __shared__ float Vs[64][64];
    const int tid = threadIdx.x, u = blockIdx.y, q = blockIdx.x * 256 + tid;
    int qu, kgrp, vgrp, ndb, dboff;
    if (mode == 0) { const int b = u >> 3, h = u & 7; qu = u; kgrp = b * 2 + (h >> 2); vgrp = kgrp; ndb = 2; dboff = 0; }
    else { const int dh = u & 1, bs = u >> 1, b = bs >> 3, sh = bs & 7; qu = bs; kgrp = bs; vgrp = b * 4 + (sh >> 1); ndb = 4; dboff = 64 * dh; }
    float mq = 0.f, mk = 0.f;
    for (int d = 0; d < 64; ++d) { mq = fmaxf(mq, fabsf(gq[d])); mk = fmaxf(mk, fabsf(gk[d])); }
    const float Mc = 8.f * mq * mk * LOG2E;
    float qv[64], o[64]; float l = 0.f;
    const bf16_t* qp = Q + ((size_t)qu * SEQ + q) * 64;
#pragma unroll
    for (int d = 0; d < 64; ++d) { qv[d] = bf2f(qp[d]); o[d] = 0.f; }
    for (int tile = 0; tile < NT_KV; ++tile) {
        for (int i = 0; i < 16; ++i) { const int e = tid * 16 + i, key = e >> 6, d = e & 63;
            Ks[key][d] = bf2f(K[kidx(kgrp, tile * 64 + key, d)]); Vs[key][d] = bf2f(V[vidx(vgrp, tile * 64 + key, dboff + d, ndb)]); }
        __syncthreads();
        const int nk = tile == 0 ? NMETA : 64;
        for (int key = 0; key < nk; ++key) {
            float s = -Mc;
#pragma unroll
            for (int d = 0; d < 64; ++d) s += qv[d] * Ks[key][d];
            const float p = exp2f(s); l += p;
#pragma unroll
            for (int d = 0; d < 64; ++d) o[d] += p * Vs[key][d];
        }
        __syncthreads();
    }
    const float il = 1.f / l; float* op = O + ((size_t)u * SEQ + q) * 64;
#pragma unroll
    for (int d = 0; d < 64; ++d) op[d] = o[d] * il;
}

__global__ void __launch_bounds__(256) nk_mix(const float* OA, const float* OB, bf16_t* MIX, const float* lq1, const float* lk1, const float* lq2, const float* lk2, const float* subg) {
    const int idx = blockIdx.x * 256 + threadIdx.x; const int row = idx / 12, part = idx % 12;
    if (row >= NTOK) return;
    const int b = row / SEQ, t = row % SEQ;
    if (part < 8) { const float* s = OA + ((size_t)(b * 8 + part) * SEQ + t) * 64; bf16_t* d = MIX + (size_t)row * DM + part * 64; for (int i = 0; i < 64; ++i) d[i] = (bf16_t)f2bf(s[i]); return; }
    const int hb = part - 8;
    float s1 = 0.f, s2 = 0.f; for (int i = 0; i < 64; ++i) { s1 += lq1[i] * lk1[i]; s2 += lq2[i] * lk2[i]; }
    const float lam = expf(s1) - expf(s2) + LAM_INIT;
    const float* o0 = OB + ((size_t)((b * 8 + 2 * hb) * 2) * SEQ) * 64;
    const float* o1 = OB + ((size_t)((b * 8 + 2 * hb + 1) * 2) * SEQ) * 64;
    float ss = 0.f;
    for (int d = 0; d < 128; ++d) { const size_t off = ((size_t)(d >> 6) * SEQ + t) * 64 + (d & 63); const float v = o0[off] - lam * o1[off]; ss += v * v; }
    const float rn = rsqrtf(ss * (1.f / 128.f) + EPS) * (1.f - LAM_INIT);
    bf16_t* dst = MIX + (size_t)row * DM + 512 + hb * 128;
    for (int d = 0; d < 128; ++d) { const size_t off = ((size_t)(d >> 6) * SEQ + t) * 64 + (d & 63); const float v = o0[off] - lam * o1[off]; dst[d] = (bf16_t)f2bf(v * rn * subg[d]); }
}

struct AL3 { const bf16_t* a; int lda; int pad; __device__ float operator()(int row, int k) const { return bf2f(a[(size_t)row * lda + k]); } };
struct WLp { const float* w; int ldw; int pad; __device__ float operator()(int, int k, int col) const { return w[(size_t)k * ldw + col]; } };
struct EP3 { const float* x; float* x1; bf16_t* x1b; __device__ void operator()(int row, int col, float v, float) const { const size_t o = (size_t)row * DM + col; const float r = x[o] + v; x1[o] = r; x1b[o] = (bf16_t)f2bf(r); } };
struct AL4 { const float* x1; const float* ss; const float* g; __device__ float operator()(int row, int k) const { return x1[(size_t)row * DM + k] * rsqrtf(ss[row] * (1.f / DM) + EPS) * g[k]; } };
struct WL4 { const float* wg; const float* wu; __device__ float operator()(int w, int k, int col) const { return (w ? wu : wg)[(size_t)k * DFF + col]; } };
struct EP4 { bf16_t* hid; __device__ void operator()(int row, int col, float g, float u) const { const float s = g / (1.f + __expf(-g)); hid[(size_t)row * DFF + col] = (bf16_t)f2bf(s * u); } };
struct EP5 { float* out; __device__ void operator()(int row, int col, float v, float) const { out[(size_t)row * DM + col] += v; } };

namespace pg8 {
#define PG8_LAS __attribute__((address_space(3)))
typedef unsigned short bf16_t;
typedef short bf16x8 __attribute__((ext_vector_type(8)));
typedef float f32x4 __attribute__((ext_vector_type(4)));
typedef unsigned u32x4 __attribute__((ext_vector_type(4)));
constexpr int BM = 256, BK = 64, HALF = 128, HTB = HALF * BK * 2  , STAGE_BYTES = 8 * HTB, NXCD = 8, WGM = 8;

__host__ __device__ __forceinline__ int lds_byte(int r, int c) { const int st = (r >> 4) * 2 + (c >> 5), rr = r & 15, cc = c & 31, ob = rr * 64 + cc * 2; return st * 1024 + (ob ^ (((ob >> 9) & 1) << 5)); }
__host__ __device__ __forceinline__ void stage_rc(int b, int& R, int& C) { const int st = b / 1024, sb = b % 1024, swz = sb ^ (((sb >> 9) & 1) << 5); R = (st >> 1) * 16 + swz / 64; C = (st & 1) * 32 + (swz % 64) / 2; }
__host__ __device__ __forceinline__ int perm32(int rho) { const int n = rho >> 4, i = rho & 15; return 8 * (i >> 2) + 4 * n + (i & 3); }

struct Unit { int pm, pn; };
struct Gemm { const bf16_t* A; const bf16_t* Bt; int M, N, K; };

struct StaticOrder {
    int nM, nN, nwg, G, c;
    __host__ __device__ void init(int M, int N, int G_, int c_) { nM = M / BM; nN = N / BM; nwg = nM * nN; G = G_; c = c_; }
    __host__ __device__ bool next(int i, Unit& u) const {
        const long L = (long)i * G + c; if (L >= nwg) return false;
        int wgid = (int)L; { const int q = nwg / NXCD, r = nwg % NXCD, xcd = wgid % NXCD, off = wgid / NXCD; wgid = (xcd < r ? xcd * (q + 1) : r * (q + 1) + (xcd - r) * q) + off; }
        const int nig = WGM * nN, gid = wgid / nig, fm = gid * WGM, gsz = (nM - fm) < WGM ? (nM - fm) : WGM;
        u.pm = fm + ((wgid % nig) % gsz); u.pn = (wgid % nig) / gsz; return true;
    }
    __device__ __forceinline__ void a_ready(const Unit&) const {}
    __device__ __forceinline__ void done(const Unit&) const {}
};

__device__ __forceinline__ unsigned cvt_pk_bf16(float lo, float hi) { unsigned r; asm volatile("v_cvt_pk_bf16_f32 %0, %1, %2" : "=v"(r) : "v"(lo), "v"(hi)); return r; }

struct EpiProj {
    static constexpr bool PERM = true, AFTER_DRAIN = false;
    const float* ss; const float* GT; const float* TAB; bf16_t* wsb;
    static constexpr size_t TBOFF = (WS_TB - WS_TA) / 4, O_QA = WS_QA / 2, O_QB = WS_QB / 2, O_KA = WS_KA / 2, O_VA = WS_VA / 2, O_KB = WS_KB / 2, O_VB = WS_VB / 2;
    __device__ __forceinline__ void operator()(const f32x4 (&acc)[2][2][4][2], const Unit& u, int wr, int wc, int fr_, int fq_) const {
        int fr = fr_, fq = fq_; asm volatile("" : "+v"(fr), "+v"(fq));
        const int slot = u.pn * 4 + wc; const bool metaT = (u.pm == 128);
        int type, hh;
        if (slot < 8) { type = 0; hh = slot; } else if (slot < 10) { type = 1; hh = slot - 8; } else if (slot < 12) { type = 2; hh = slot - 10; }
        else if (slot < 20) { type = 3; hh = slot - 12; } else if (slot < 28) { type = 4; hh = slot - 20; } else { type = 5; hh = slot - 28; }
        if (metaT && (type == 0 || type == 3)) return;
        const bool isB = type >= 3, normed = (type != 2 && type != 5), isQ = (type == 0 || type == 3);
        const int gi = type == 0 ? 0 : type == 1 ? 1 : type == 3 ? 2 : 3;
        f32x4 gv[2][2];
#pragma unroll
        for (int bj = 0; bj < 2; ++bj)
#pragma unroll
            for (int n = 0; n < 2; ++n) gv[bj][n] = *(const f32x4*)(GT + gi * 64 + 32 * bj + 8 * fq + 4 * n);
        const int b = u.pm >> 4, tbase = (u.pm & 15) * 256;
        size_t obase, bstride; int tilesz;
        if (type == 0)      { obase = O_QA + (size_t)hh * 4096 * 64; bstride = (size_t)8 * 4096 * 64; tilesz = 0; }
        else if (type == 3) { obase = O_QB + (size_t)hh * 4096 * 64; bstride = (size_t)8 * 4096 * 64; tilesz = 0; }
        else if (type == 1) { obase = O_KA + (size_t)hh * 65 * 4096; bstride = (size_t)2 * 65 * 4096; tilesz = 4096; }
        else if (type == 4) { obase = O_KB + (size_t)hh * 65 * 4096; bstride = (size_t)8 * 65 * 4096; tilesz = 4096; }
        else if (type == 2) { obase = O_VA + (size_t)hh * 65 * 4096; bstride = (size_t)2 * 65 * 4096; tilesz = 4096; }
        else                { obase = O_VB + (size_t)(hh >> 1) * 65 * 8192 + (size_t)((hh & 1) * 2) * 2048; bstride = (size_t)4 * 65 * 8192; tilesz = 8192; }
        const bool isK = (type == 1 || type == 4);
#pragma unroll
        for (int ai = 0; ai < 2; ++ai)
#pragma unroll
            for (int m = 0; m < 4; ++m) {
                if (metaT && (ai | m | wr)) continue;
                const int rloc = ai * 128 + wr * 64 + m * 16 + fr, row = u.pm * 256 + rloc, t = tbase + rloc;
                const float rsx = __builtin_amdgcn_rsqf(ss[row] * (1.f / 1024.f) + 1e-6f);
                f32x4 y[2][2]; float s = 0.f;
#pragma unroll
                for (int bj = 0; bj < 2; ++bj)
#pragma unroll
                    for (int n = 0; n < 2; ++n) { y[bj][n] = acc[ai][bj][m][n] * rsx; const f32x4 q = y[bj][n] * y[bj][n]; s += (q[0] + q[1]) + (q[2] + q[3]); }
                if (normed) {
                    s += __shfl_xor(s, 16); s += __shfl_xor(s, 32);
                    const float rn = __builtin_amdgcn_rsqf(s * (1.f / 64.f) + 1e-6f) * (isQ ? 0.18033688011112042f : 1.f);
                    const float* T = TAB + (isB ? TBOFF + (size_t)(metaT ? rloc : 16 + t) * 64 : (size_t)(metaT ? 4096 : t) * 64);
#pragma unroll
                    for (int bj = 0; bj < 2; ++bj)
#pragma unroll
                        for (int n = 0; n < 2; ++n) {
                            const f32x4 cs = *(const f32x4*)(T + (16 * bj + 4 * fq + 2 * n) * 2);
                            const f32x4 v = y[bj][n] * gv[bj][n] * rn;
                            y[bj][n] = (f32x4){v[0] * cs[0] - v[1] * cs[1], v[0] * cs[1] + v[1] * cs[0], v[2] * cs[2] - v[3] * cs[3], v[2] * cs[3] + v[3] * cs[2]};
                        }
                }
                u32x4 w[2];
#pragma unroll
                for (int bj = 0; bj < 2; ++bj) { w[bj].x = cvt_pk_bf16(y[bj][0][0], y[bj][0][1]); w[bj].y = cvt_pk_bf16(y[bj][0][2], y[bj][0][3]); w[bj].z = cvt_pk_bf16(y[bj][1][0], y[bj][1][1]); w[bj].w = cvt_pk_bf16(y[bj][1][2], y[bj][1][3]); }
                size_t off; int step;
                if (isQ) { off = (size_t)t * 64 + 8 * fq; step = 32; }
                else { const int krow = metaT ? rloc : 64 + t, tile = krow >> 6, key = krow & 63;
                    if (isK) { off = (size_t)tile * tilesz + fq * 512 + key * 8; step = 2048; } else { off = (size_t)tile * tilesz + key * 32 + 8 * fq; step = 2048; } }
                for (int bb = (metaT ? 0 : b); bb < (metaT ? 8 : b + 1); ++bb) { bf16_t* p = wsb + obase + (size_t)bb * bstride + off; *(u32x4*)(p) = w[0]; *(u32x4*)(p + step) = w[1]; }
                asm volatile("" ::: "memory");
            }
    }
};

struct EpiRes1 {
    static constexpr bool PERM = true, AFTER_DRAIN = false;
    const float* x; float* out; bf16_t* x1b; float* ss2;
    __device__ __forceinline__ void operator()(const f32x4 (&acc)[2][2][4][2], const Unit& u, int wr, int wc, int fr, int fq) const {
#pragma unroll
        for (int ai = 0; ai < 2; ++ai)
#pragma unroll
            for (int m = 0; m < 4; ++m) {
                const int row = u.pm * 256 + ai * 128 + wr * 64 + m * 16 + fr; float s = 0.f;
#pragma unroll
                for (int bj = 0; bj < 2; ++bj) {
                    const size_t off = (size_t)row * 1024 + u.pn * 256 + bj * 128 + wc * 32 + 8 * fq;
                    const f32x4 a0 = *(const f32x4*)(x + off) + acc[ai][bj][m][0], a1 = *(const f32x4*)(x + off + 4) + acc[ai][bj][m][1];
                    *(f32x4*)(out + off) = a0; *(f32x4*)(out + off + 4) = a1;
                    u32x4 w; w.x = cvt_pk_bf16(a0[0], a0[1]); w.y = cvt_pk_bf16(a0[2], a0[3]); w.z = cvt_pk_bf16(a1[0], a1[1]); w.w = cvt_pk_bf16(a1[2], a1[3]);
                    *(u32x4*)(x1b + off) = w;
                    const f32x4 q0 = a0 * a0, q1 = a1 * a1; s += ((q0[0] + q0[1]) + (q0[2] + q0[3])) + ((q1[0] + q1[1]) + (q1[2] + q1[3]));
                }
                s += __shfl_xor(s, 16); s += __shfl_xor(s, 32);
                if (fq == 0) atomicAdd(ss2 + row, s);
            }
    }
};

struct EpiSwiglu {
    static constexpr bool PERM = true, AFTER_DRAIN = false;
    const float* ss2; bf16_t* hid;
    __device__ __forceinline__ void operator()(const f32x4 (&acc)[2][2][4][2], const Unit& u, int wr, int wc, int fr, int fq) const {
#pragma unroll
        for (int ai = 0; ai < 2; ++ai)
#pragma unroll
            for (int m = 0; m < 4; ++m) {
                const int row = u.pm * 256 + ai * 128 + wr * 64 + m * 16 + fr;
                const float r = __builtin_amdgcn_rsqf(ss2[row] * (1.f / 1024.f) + 1e-6f);
                float h[8];
#pragma unroll
                for (int n = 0; n < 2; ++n)
#pragma unroll
                    for (int i = 0; i < 4; ++i) { const float g = acc[ai][0][m][n][i] * r, uu = acc[ai][1][m][n][i] * r;
                        h[n * 4 + i] = g * __builtin_amdgcn_rcpf(1.f + __builtin_amdgcn_exp2f(-1.4426950408889634f * g)) * uu; }
                u32x4 w; w.x = cvt_pk_bf16(h[0], h[1]); w.y = cvt_pk_bf16(h[2], h[3]); w.z = cvt_pk_bf16(h[4], h[5]); w.w = cvt_pk_bf16(h[6], h[7]);
                *(u32x4*)(hid + (size_t)row * 2816 + u.pn * 128 + wc * 32 + 8 * fq) = w;
            }
    }
};

struct EpiRes2 {
    static constexpr bool PERM = true, AFTER_DRAIN = false;
    float* out;
    __device__ __forceinline__ void operator()(const f32x4 (&acc)[2][2][4][2], const Unit& u, int wr, int wc, int fr, int fq) const {
#pragma unroll
        for (int ai = 0; ai < 2; ++ai)
#pragma unroll
            for (int m = 0; m < 4; ++m) {
                const int row = u.pm * 256 + ai * 128 + wr * 64 + m * 16 + fr;
#pragma unroll
                for (int bj = 0; bj < 2; ++bj) {
                    float* p = out + (size_t)row * 1024 + u.pn * 256 + bj * 128 + wc * 32 + 8 * fq;
                    *(f32x4*)(p) = *(const f32x4*)(p) + acc[ai][bj][m][0]; *(f32x4*)(p + 4) = *(const f32x4*)(p + 4) + acc[ai][bj][m][1];
                }
            }
    }
};
template <class Epi, class Sched, bool ALIGN_EPI = false, bool SP2 = false>
__device__ __forceinline__ void gemm_phase(PG8_LAS unsigned char* lds, const Gemm g, const Sched& S, const Epi& E) {
    const int tid = threadIdx.x, wid = __builtin_amdgcn_readfirstlane(tid >> 6), lane = tid & 63, wr = wid >> 2, wc = wid & 3, fr = lane & 15, fq = lane >> 4;
    const int K = g.K, nt = K / BK;
    unsigned voffA[2], voffB[2];
#pragma unroll
    for (int i = 0; i < 2; ++i) { int R, C; stage_rc(tid * 16 + i * 8192, R, C); const int Rb = Epi::PERM ? ((R & ~31) + perm32(R & 31)) : R;
        voffA[i] = (unsigned)(R * K + C) * 2u; voffB[i] = (unsigned)(Rb * K + C) * 2u; }
    const size_t kstep = (size_t)(BK * 2);
    const size_t hstep = (size_t)HALF * K * 2;
    const size_t tstep = 2 * hstep;
    const unsigned ldsw = (unsigned)wid * 1024u;
    const int aoff = lds_byte(wr * 64 + fr, fq * 8), boff = lds_byte(wc * 32 + fr, fq * 8);
#define PG8_SA(b, h) (((b) * 2 + (h)) * HTB)
#define PG8_SB(b, h) ((4 + (b) * 2 + (h)) * HTB)
#define PG8_STAGE(bufoff, gbase, voff) do { _Pragma("unroll") for (int _i = 0; _i < 2; ++_i) \
        __builtin_amdgcn_global_load_lds((const unsigned*)((const char*)(gbase) + (voff)[_i]), (PG8_LAS unsigned*)(lds + (bufoff) + ldsw + _i * 8192), 16, 0, 0); } while (0)
#define PG8_LDA(dst, b, h) do { _Pragma("unroll") for (int m = 0; m < 4; ++m) _Pragma("unroll") for (int k = 0; k < 2; ++k) dst[m][k] = *(const PG8_LAS bf16x8*)(lds + PG8_SA(b, h) + aoff + m * 2048 + k * 1024); } while (0)
#define PG8_LDB(dst, b, h) do { _Pragma("unroll") for (int n = 0; n < 2; ++n) _Pragma("unroll") for (int k = 0; k < 2; ++k) dst[n][k] = *(const PG8_LAS bf16x8*)(lds + PG8_SB(b, h) + boff + n * 2048 + k * 1024); } while (0)
#define PG8_MMA(ai, bj, At, Bt) do { __builtin_amdgcn_s_setprio(1); _Pragma("unroll") for (int m = 0; m < 4; ++m) _Pragma("unroll") for (int n = 0; n < 2; ++n) _Pragma("unroll") for (int k = 0; k < 2; ++k) \
        acc[ai][bj][m][n] = __builtin_amdgcn_mfma_f32_16x16x32_bf16(Bt[n][k], At[m][k], acc[ai][bj][m][n], 0, 0, 0); __builtin_amdgcn_s_setprio(0); } while (0)
#define PG8_WAIT_V(n) asm volatile("s_waitcnt vmcnt(" #n ")" ::: "memory")
#define PG8_WAIT_L(n) asm volatile("s_waitcnt lgkmcnt(" #n ")" ::: "memory")
#define PG8_BAR __builtin_amdgcn_s_barrier()
#define PG8_SCHED __builtin_amdgcn_sched_barrier(0)
    Unit cur, nxt; int ui = 0;
    if (!S.next(0, cur)) return;
    f32x4 acc[2][2][4][2];
#pragma unroll
    for (int a = 0; a < 2; ++a)
#pragma unroll
        for (int b = 0; b < 2; ++b)
#pragma unroll
            for (int m = 0; m < 4; ++m)
#pragma unroll
                for (int n = 0; n < 2; ++n) acc[a][b][m][n] = (f32x4){0.f, 0.f, 0.f, 0.f};
    bf16x8 At[4][2], B0[2][2], B1[2][2];
    const char* cA = (const char*)g.A + (size_t)cur.pm * tstep; const char* cB = (const char*)g.Bt + (size_t)cur.pn * tstep;
    S.a_ready(cur);
    if constexpr (SP2) {
        PG8_STAGE(PG8_SB(0, 0), cB, voffB); PG8_STAGE(PG8_SB(0, 1), cB + hstep, voffB); PG8_STAGE(PG8_SA(0, 0), cA, voffA); PG8_STAGE(PG8_SA(0, 1), cA + hstep, voffA);
        if (wr == 1) PG8_BAR;
        PG8_WAIT_V(2); PG8_BAR;
        PG8_STAGE(PG8_SB(1, 0), cB + kstep, voffB); PG8_STAGE(PG8_SA(1, 0), cA + kstep, voffA); PG8_STAGE(PG8_SB(1, 1), cB + hstep + kstep, voffB);
        PG8_WAIT_V(6); PG8_BAR;
    } else {
        PG8_STAGE(PG8_SB(0, 0), cB, voffB); PG8_STAGE(PG8_SA(0, 0), cA, voffA); PG8_STAGE(PG8_SB(0, 1), cB + hstep, voffB); PG8_STAGE(PG8_SA(0, 1), cA + hstep, voffA);
        if (wr == 1) PG8_BAR;
        PG8_WAIT_V(4); PG8_BAR;
        PG8_STAGE(PG8_SB(1, 0), cB + kstep, voffB); PG8_STAGE(PG8_SA(1, 0), cA + kstep, voffA); PG8_STAGE(PG8_SB(1, 1), cB + hstep + kstep, voffB);
        PG8_WAIT_V(6); PG8_BAR;
    }
    for (;;) {
        const bool has_next = S.next(ui + 1, nxt);
        const char* nA = has_next ? (const char*)g.A + (size_t)nxt.pm * tstep : cA; const char* nB = has_next ? (const char*)g.Bt + (size_t)nxt.pn * tstep : cB;
        for (int t = 0; t < nt; t += 2) {
            const bool last = (t == nt - 2);
            const char* a1 = cA + (size_t)(t + 1) * kstep;
            const char* a2 = last ? nA : cA + (size_t)(t + 2) * kstep; const char* b2 = last ? nB : cB + (size_t)(t + 2) * kstep;
            const char* a3 = a2 + kstep; const char* b3 = b2 + kstep;
            if (last && has_next) S.a_ready(nxt);
            if constexpr (SP2) {
            PG8_LDB(B0, 0, 0); PG8_LDB(B1, 0, 1); PG8_SCHED; PG8_LDA(At, 0, 0); PG8_STAGE(PG8_SA(1, 1), a1 + hstep, voffA);
            PG8_WAIT_V(8); PG8_WAIT_L(0); PG8_BAR; PG8_MMA(0, 0, At, B0); PG8_MMA(0, 1, At, B1); PG8_BAR; PG8_SCHED;
            PG8_LDA(At, 0, 1); PG8_STAGE(PG8_SB(0, 0), b2, voffB); PG8_STAGE(PG8_SB(0, 1), b2 + hstep, voffB); PG8_STAGE(PG8_SA(0, 0), a2, voffA);
            PG8_WAIT_V(8); PG8_WAIT_L(0); PG8_BAR; PG8_MMA(1, 0, At, B0); PG8_MMA(1, 1, At, B1); PG8_BAR; PG8_SCHED;
            PG8_LDB(B0, 1, 0); PG8_LDB(B1, 1, 1); PG8_SCHED; PG8_LDA(At, 1, 0); PG8_STAGE(PG8_SA(0, 1), a2 + hstep, voffA);
            PG8_WAIT_V(8); PG8_WAIT_L(0); PG8_BAR; PG8_MMA(0, 0, At, B0); PG8_MMA(0, 1, At, B1); PG8_BAR; PG8_SCHED;
            PG8_LDA(At, 1, 1); PG8_STAGE(PG8_SB(1, 0), b3, voffB); PG8_STAGE(PG8_SB(1, 1), b3 + hstep, voffB); PG8_STAGE(PG8_SA(1, 0), a3, voffA);
            PG8_WAIT_V(8); PG8_WAIT_L(0); PG8_BAR; PG8_MMA(1, 0, At, B0); PG8_MMA(1, 1, At, B1); PG8_BAR; PG8_SCHED;
            } else {
            PG8_LDB(B0, 0, 0); PG8_SCHED; PG8_LDA(At, 0, 0); PG8_STAGE(PG8_SA(1, 1), a1 + hstep, voffA);
            PG8_WAIT_L(8); PG8_BAR; PG8_WAIT_L(0); PG8_MMA(0, 0, At, B0); PG8_BAR; PG8_SCHED;
            PG8_LDB(B1, 0, 1); PG8_STAGE(PG8_SB(0, 0), b2, voffB);
            PG8_BAR; PG8_WAIT_L(0); PG8_MMA(0, 1, At, B1); PG8_BAR;
            PG8_LDA(At, 0, 1); PG8_STAGE(PG8_SA(0, 0), a2, voffA);
            PG8_BAR; PG8_WAIT_L(0); PG8_MMA(1, 0, At, B0); PG8_BAR; PG8_SCHED;
            PG8_STAGE(PG8_SB(0, 1), b2 + hstep, voffB);
            PG8_WAIT_V(6); PG8_BAR; PG8_MMA(1, 1, At, B1); PG8_BAR;
            PG8_LDB(B0, 1, 0); PG8_SCHED; PG8_LDA(At, 1, 0); PG8_STAGE(PG8_SA(0, 1), a2 + hstep, voffA);
            PG8_WAIT_L(8); PG8_BAR; PG8_WAIT_L(0); PG8_MMA(0, 0, At, B0); PG8_BAR; PG8_SCHED;
            PG8_LDB(B1, 1, 1); PG8_STAGE(PG8_SB(1, 0), b3, voffB);
            PG8_BAR; PG8_WAIT_L(0); PG8_MMA(0, 1, At, B1); PG8_BAR;
            PG8_LDA(At, 1, 1); PG8_STAGE(PG8_SA(1, 0), a3, voffA);
            PG8_BAR; PG8_WAIT_L(0); PG8_MMA(1, 0, At, B0); PG8_BAR; PG8_SCHED;
            PG8_STAGE(PG8_SB(1, 1), b3 + hstep, voffB);
            PG8_WAIT_V(6); PG8_BAR; PG8_MMA(1, 1, At, B1); PG8_BAR;
            }
        }
        if constexpr (ALIGN_EPI) { if (wr == 0) PG8_BAR; }
        if constexpr (!Epi::AFTER_DRAIN) { E(acc, cur, wr, wc, fr, fq); S.done(cur); }
        if (!has_next) break;
#pragma unroll
        for (int a = 0; a < 2; ++a)
#pragma unroll
            for (int b = 0; b < 2; ++b)
#pragma unroll
                for (int m = 0; m < 4; ++m)
#pragma unroll
                    for (int n = 0; n < 2; ++n) acc[a][b][m][n] = (f32x4){0.f, 0.f, 0.f, 0.f};
        cur = nxt; cA = nA; cB = nB; ++ui;
        if constexpr (ALIGN_EPI) { if (wr == 1) PG8_BAR; }
    }
    PG8_WAIT_V(0);
    if constexpr (!ALIGN_EPI) { if (wr == 0) PG8_BAR; }
    PG8_BAR;
    if constexpr (Epi::AFTER_DRAIN) { E.fused(acc, cur, wr, wc, fr, fq, lds, wid, lane); S.done(cur); }
#undef PG8_SA
#undef PG8_SB
#undef PG8_STAGE
#undef PG8_LDA
#undef PG8_LDB
#undef PG8_MMA
#undef PG8_WAIT_V
#undef PG8_WAIT_L
#undef PG8_BAR
#undef PG8_SCHED
}
}
namespace att {
using bf16x8 = __attribute__((ext_vector_type(8))) short;
using s16x4 = __attribute__((ext_vector_type(4))) short;
using f32x16 = __attribute__((ext_vector_type(16))) float;
using u32x4 = __attribute__((ext_vector_type(4))) unsigned;
typedef short v4i16_t __attribute__((ext_vector_type(4)));
typedef __attribute__((address_space(3))) const char* lds_cptr;
typedef __attribute__((address_space(3))) char* lds_ptr;
constexpr int L_K = 0, L_V = 16384, L_WS = 49152, L_OST = 51200, L_END = L_OST + 8 * 8192;
__device__ __forceinline__ int crow(int r, int hi) { return (r & 3) + 8 * (r >> 2) + 4 * hi; }
__device__ __forceinline__ unsigned cvtpk(float lo, float hi) { unsigned r; asm volatile("v_cvt_pk_bf16_f32 %0, %1, %2" : "=v"(r) : "v"(lo), "v"(hi)); return r; }
__device__ __forceinline__ s16x4 vtr(lds_cptr p) { return __builtin_bit_cast(s16x4, __builtin_amdgcn_ds_read_tr16_b64_v4i16((__attribute__((address_space(3))) v4i16_t*)p)); }
__device__ __forceinline__ float wave_max(float v) { for (int o = 1; o < 64; o <<= 1) v = fmaxf(v, __shfl_xor(v, o)); return v; }
__device__ __forceinline__ float wave_sum(float v) { for (int o = 1; o < 64; o <<= 1) v += __shfl_xor(v, o); return v; }

template <int NDB>
__device__ __forceinline__ void sweep(const bf16_t* Qp, const bf16_t* Kt, const bf16_t* Vt, float negMc, lds_ptr shm, f32x16 (&o)[NDB], float& l_out) {
    const int tid = threadIdx.x, lane = tid & 63, r32 = lane & 31, hi = lane >> 5; const int wid = __builtin_amdgcn_readfirstlane(tid >> 6);
    bf16x8 qr[4];
#pragma unroll
    for (int d0 = 0; d0 < 4; ++d0) qr[d0] = *(const bf16x8*)(Qp + (size_t)(wid * 32 + r32) * 64 + d0 * 16 + hi * 8);
#pragma unroll
    for (int db = 0; db < NDB; ++db)
#pragma unroll
        for (int r = 0; r < 16; ++r) o[db][r] = 0.f;
    float l = 0.f;
    const u32x4* kg = (const u32x4*)Kt + tid; const u32x4* vg = (const u32x4*)Vt + tid;
    u32x4 kreg = kg[0]; u32x4 vreg[NDB / 2];
#pragma unroll
    for (int i = 0; i < NDB / 2; ++i) vreg[i] = vg[i * 512];
    *(__attribute__((address_space(3))) u32x4*)(shm + L_K + tid * 16) = kreg;
#pragma unroll
    for (int i = 0; i < NDB / 2; ++i) *(__attribute__((address_space(3))) u32x4*)(shm + L_V + i * 8192 + tid * 16) = vreg[i];
    __syncthreads();
    const lds_cptr kp0 = (lds_cptr)shm + L_K + hi * 1024 + r32 * 16;
    const lds_cptr vp0 = (lds_cptr)shm + L_V + ((lane >> 4) & 1) * 32 + (lane & 3) * 8 + (4 * hi + ((lane & 15) >> 2)) * 64;
    for (int t = 0; t < 65; ++t) {
        const int cur = t & 1;
        if (t + 1 < 65) { kreg = kg[(size_t)(t + 1) * 512];
#pragma unroll
            for (int i = 0; i < NDB / 2; ++i) vreg[i] = vg[(size_t)(t + 1) * (NDB * 256) + i * 512]; }
        const lds_cptr kp = kp0 + cur * 8192; const lds_cptr vp = vp0 + cur * 16384;
        float nm = negMc; asm volatile("" : "+v"(nm));
        const float big = (t == 0) ? -30000.f : nm;
        f32x16 c0, c1;
#pragma unroll
        for (int r = 0; r < 16; ++r) { c0[r] = (r < 8) ? nm : big; c1[r] = big; }
#pragma unroll
        for (int d0 = 0; d0 < 4; ++d0) {
            const bf16x8 b0 = *(const __attribute__((address_space(3))) bf16x8*)(kp + d0 * 2048);
            const bf16x8 b1 = *(const __attribute__((address_space(3))) bf16x8*)(kp + d0 * 2048 + 512);
            c0 = __builtin_amdgcn_mfma_f32_32x32x16_bf16(b0, qr[d0], c0, 0, 0, 0);
            c1 = __builtin_amdgcn_mfma_f32_32x32x16_bf16(b1, qr[d0], c1, 0, 0, 0);
        }
        __builtin_amdgcn_sched_barrier(0);
        float sacc = 0.f;
#pragma unroll
        for (int r = 0; r < 16; ++r) { c0[r] = __builtin_amdgcn_exp2f(c0[r]); c1[r] = __builtin_amdgcn_exp2f(c1[r]); sacc += c0[r] + c1[r]; }
        l += sacc;
        u32x4 pw[4];
#pragma unroll
        for (int k = 0; k < 2; ++k) {
            pw[k] = (u32x4){cvtpk(c0[8 * k + 0], c0[8 * k + 1]), cvtpk(c0[8 * k + 2], c0[8 * k + 3]), cvtpk(c0[8 * k + 4], c0[8 * k + 5]), cvtpk(c0[8 * k + 6], c0[8 * k + 7])};
            pw[2 + k] = (u32x4){cvtpk(c1[8 * k + 0], c1[8 * k + 1]), cvtpk(c1[8 * k + 2], c1[8 * k + 3]), cvtpk(c1[8 * k + 4], c1[8 * k + 5]), cvtpk(c1[8 * k + 6], c1[8 * k + 7])};
        }
#pragma unroll
        for (int db = 0; db < NDB; ++db) {
            __builtin_amdgcn_sched_barrier(0);
#pragma unroll
            for (int ks = 0; ks < 4; ++ks) {
                const s16x4 lo = vtr(vp + db * 4096 + ks * 1024), hi4 = vtr(vp + db * 4096 + ks * 1024 + 512);
                const bf16x8 vf = (bf16x8){lo[0], lo[1], lo[2], lo[3], hi4[0], hi4[1], hi4[2], hi4[3]};
                o[db] = __builtin_amdgcn_mfma_f32_32x32x16_bf16(__builtin_bit_cast(bf16x8, pw[ks]), vf, o[db], 0, 0, 0);
            }
        }
        __builtin_amdgcn_sched_barrier(0);
        if (t + 1 < 65) {
            *(__attribute__((address_space(3))) u32x4*)(shm + L_K + (cur ^ 1) * 8192 + tid * 16) = kreg;
#pragma unroll
            for (int i = 0; i < NDB / 2; ++i) *(__attribute__((address_space(3))) u32x4*)(shm + L_V + (cur ^ 1) * 16384 + i * 8192 + tid * 16) = vreg[i];
        }
        __syncthreads();
    }
    l += __shfl_xor(l, 32);
    l_out = l;
}

__device__ __forceinline__ void inv_l_regs(float l, lds_ptr shm, int wid, int r32_, int hi_, float (&rli)[16]) {
    int r32 = r32_, hi = hi_; asm volatile("" : "+v"(r32), "+v"(hi));
    __attribute__((address_space(3))) float* wsf = (__attribute__((address_space(3))) float*)(shm + L_WS) + wid * 64;
    if (hi == 0) wsf[r32] = l;
    asm volatile("s_waitcnt lgkmcnt(0)" ::: "memory");
    const __attribute__((address_space(3))) float* rp = wsf + 4 * hi;
#pragma unroll
    for (int r = 0; r < 16; ++r) rli[r] = __builtin_amdgcn_rcpf(rp[(r & 3) + 8 * (r >> 2)]);
    asm volatile("s_waitcnt lgkmcnt(0)" ::: "memory");
}
template <int NDB>
__device__ __forceinline__ void store_rows(const f32x16 (&v)[NDB], lds_ptr shm, int wid, int lane_, bf16_t* dst) {
    int lane = lane_; asm volatile("" : "+v"(lane));
    const int r32 = lane & 31, hi = lane >> 5;
    __attribute__((address_space(3))) bf16_t* stg = (__attribute__((address_space(3))) bf16_t*)(shm + L_OST + wid * 8192);
    __attribute__((address_space(3))) bf16_t* wp = stg + (4 * hi) * (NDB * 32) + r32;
#pragma unroll
    for (int r = 0; r < 16; ++r)
#pragma unroll
        for (int db = 0; db < NDB; ++db) wp[((r & 3) + 8 * (r >> 2)) * (NDB * 32) + db * 32] = (bf16_t)f2bf(v[db][r]);
    asm volatile("s_waitcnt lgkmcnt(0)" ::: "memory");
    constexpr int CPR = NDB * 4;
    const int row0 = lane / CPR, ch = lane % CPR;
    const __attribute__((address_space(3))) bf16_t* rp = stg + row0 * (NDB * 32) + ch * 8; bf16_t* gp = dst + (size_t)row0 * 1024 + ch * 8;
#pragma unroll
    for (int i = 0; i < (32 * CPR) / 64; ++i) {
        const u32x4 w = *(const __attribute__((address_space(3))) u32x4*)(rp + i * (64 / CPR) * (NDB * 32));
        *(u32x4*)(gp + (size_t)i * (64 / CPR) * 1024) = w; }
    asm volatile("s_waitcnt lgkmcnt(0)" ::: "memory");
}

struct Tensors { const bf16_t *QA, *QB, *KA, *VA, *KB, *VB; bf16_t* MIX; float* stash; const float *gqa, *gka, *gqb, *gkb, *lq1, *lk1, *lq2, *lk2, *subg; };

__device__ __forceinline__ void phase(lds_ptr shm, const Tensors& T, int vcu, int G) {
    const int tid = threadIdx.x, lane = tid & 63, r32 = lane & 31, hi = lane >> 5; const int wid = __builtin_amdgcn_readfirstlane(tid >> 6);
    const float McA = 8.f * wave_max(fabsf(T.gqa[lane])) * wave_max(fabsf(T.gka[lane])) * 1.4426950408889634f;
    const float McB = 8.f * wave_max(fabsf(T.gqb[lane])) * wave_max(fabsf(T.gkb[lane])) * 1.4426950408889634f;
    const float lam = __expf(wave_sum(T.lq1[lane] * T.lk1[lane])) - __expf(wave_sum(T.lq2[lane] * T.lk2[lane])) + 0.2f;
    for (int item = vcu; item < 1536; item += G) {
        if (item < 1024) {
            const int b = (item >> 5) & 7, j = item & 31, i = item >> 8, kvh = i >> 1, idx = (i & 1) * 32 + j, h = kvh * 4 + (idx >> 4), qb = idx & 15;
            f32x16 o[2]; float l;
            sweep<2>(T.QA + ((size_t)(b * 8 + h) * 4096 + qb * 256) * 64, T.KA + (size_t)(b * 2 + kvh) * 65 * 4096, T.VA + (size_t)(b * 2 + kvh) * 65 * 4096, -McA, shm, o, l);
            float rli[16]; inv_l_regs(l, shm, wid, r32, hi, rli);
#pragma unroll
            for (int db = 0; db < 2; ++db)
#pragma unroll
                for (int r = 0; r < 16; ++r) o[db][r] *= rli[r];
            store_rows<2>(o, shm, wid, lane, T.MIX + (size_t)(b * 4096 + qb * 256 + wid * 32) * 1024 + h * 64);
        } else {
            const int wb = item - 1024, b = (wb >> 5) & 7, j = wb & 31, i = wb >> 8, idx = i * 32 + j, hb = idx >> 4, qb = idx & 15;
            float* st = T.stash + ((size_t)(blockIdx.x * 8 + wid) * 64) * 64 + lane;
            asm volatile("" : "+v"(st));
            f32x16 o[4]; float l; float rli[16];
            sweep<4>(T.QB + ((size_t)(b * 8 + 2 * hb) * 4096 + qb * 256) * 64, T.KB + (size_t)(b * 8 + 2 * hb) * 65 * 4096, T.VB + (size_t)(b * 4 + hb) * 65 * 8192, -McB, shm, o, l);
            inv_l_regs(l, shm, wid, r32, hi, rli);
#pragma unroll
            for (int db = 0; db < 4; ++db)
#pragma unroll
                for (int r = 0; r < 16; ++r) st[(db * 16 + r) * 64] = o[db][r] * rli[r];
            sweep<4>(T.QB + ((size_t)(b * 8 + 2 * hb + 1) * 4096 + qb * 256) * 64, T.KB + (size_t)(b * 8 + 2 * hb + 1) * 65 * 4096, T.VB + (size_t)(b * 4 + hb) * 65 * 8192, -McB, shm, o, l);
            inv_l_regs(l, shm, wid, r32, hi, rli);
            asm volatile("" : "+v"(st));
            float ssq[16];
#pragma unroll
            for (int r = 0; r < 16; ++r) ssq[r] = 0.f;
#pragma unroll
            for (int db = 0; db < 4; ++db)
#pragma unroll
                for (int r = 0; r < 16; ++r) { const float v = st[(db * 16 + r) * 64] - lam * (o[db][r] * rli[r]); o[db][r] = v; ssq[r] += v * v; }
#pragma unroll
            for (int r = 0; r < 16; ++r) { float s = ssq[r]; s += __shfl_xor(s, 1); s += __shfl_xor(s, 2); s += __shfl_xor(s, 4); s += __shfl_xor(s, 8); s += __shfl_xor(s, 16);
                ssq[r] = __builtin_amdgcn_rsqf(s * (1.f / 128.f) + 1e-6f) * 0.8f; }
#pragma unroll
            for (int db = 0; db < 4; ++db) { const float g = T.subg[db * 32 + r32];
#pragma unroll
                for (int r = 0; r < 16; ++r) o[db][r] *= ssq[r] * g; }
            store_rows<4>(o, shm, wid, lane, T.MIX + (size_t)(b * 4096 + qb * 256 + wid * 32) * 1024 + 512 + hb * 128);
        }
    }
}
}
#define GAS __attribute__((address_space(1)))
#define LAS __attribute__((address_space(3)))
typedef unsigned v4u __attribute__((ext_vector_type(4)));
typedef float f32x4 __attribute__((ext_vector_type(4)));
typedef GAS unsigned gu32;
typedef GAS unsigned long long gu64;
#define RLX_AGENT __ATOMIC_RELAXED, __HIP_MEMORY_SCOPE_AGENT
#define LDS_WAIT() asm volatile("s_waitcnt lgkmcnt(0)" ::: "memory")
#define VM_WAIT() asm volatile("s_waitcnt vmcnt(0)" ::: "memory")
__device__ __forceinline__ unsigned pk2(float lo, float hi) { return f2bf(lo) | (f2bf(hi) << 16); }
#define XB_TMO      128
#define XB_XCNT(j)  (256  + 64 * (j))
#define XB_XSUB(j)  (1280 + 64 * (j))
#define XB_XGEN(j)  (2304 + 64 * (j))
#define XB_TOP      3328
#define XB_TOPGEN   3392
#define XCD_BAR_WORDS 3456
#define XB_SPIN_CAP (1u << 18)

__device__ __forceinline__ unsigned xb_ld(unsigned* p)              { return __hip_atomic_load(p, __ATOMIC_RELAXED, __HIP_MEMORY_SCOPE_AGENT); }
__device__ __forceinline__ unsigned xb_add(unsigned* p, unsigned v) { return __hip_atomic_fetch_add(p, v, __ATOMIC_RELAXED, __HIP_MEMORY_SCOPE_AGENT); }
__device__ __forceinline__ unsigned xb_xcc_id() { return (unsigned)__builtin_amdgcn_s_getreg((3 << 11) | 20) & 0xFu; }
#define XB_SPIN(cond, bar) do { unsigned _sp = 0; while (cond) { __builtin_amdgcn_s_sleep(1); \
    if ((++_sp & 255u) == 0u) { if (xb_ld(&(bar)[XB_TMO])) break; if (_sp > XB_SPIN_CAP) { atomicAdd(&(bar)[XB_TMO], 1u); break; } } } } while (0)

struct XcdBarrier {
    unsigned* bar; unsigned x;
    volatile LAS unsigned* st;
};

__device__ __forceinline__ XcdBarrier xcd_barrier_post(unsigned* bar, volatile LAS unsigned* st) {
    XcdBarrier b; b.bar = bar; b.x = xb_xcc_id(); b.st = st;
    if (threadIdx.x == 0) (void)xb_add(&bar[XB_XCNT(b.x)], 1u);
    return b;
}
__device__ __forceinline__ void xcd_barrier_complete(unsigned* bar, unsigned x, unsigned& nloc, unsigned& nx) {
    const unsigned G = gridDim.x * gridDim.y * gridDim.z;
    unsigned sum, cnt, mine, sp = 0u;
    for (;;) {
        sum = 0u; cnt = 0u; mine = 0u;
#pragma unroll
        for (unsigned j = 0; j < 16; ++j) { const unsigned c = xb_ld(&bar[XB_XCNT(j)]); sum += c; cnt += (c > 0u) ? 1u : 0u; mine = (j == x) ? c : mine; }
        if (sum == G) break;
        __builtin_amdgcn_s_sleep(1);
        if ((++sp & 255u) == 0u) { if (xb_ld(&bar[XB_TMO])) break; if (sp > XB_SPIN_CAP) { atomicAdd(&bar[XB_TMO], 1u); break; } }
    }
    nloc = mine > 0u ? mine : 1u; nx = cnt > 0u ? cnt : 1u;
}

__device__ __forceinline__ void xcd_barrier(const XcdBarrier& b) {
    asm volatile("s_waitcnt vmcnt(0)" ::: "memory");
    __syncthreads();
    if (threadIdx.x == 0) {
        unsigned* bar = b.bar;
        __builtin_amdgcn_s_waitcnt(0);
        unsigned nloc = b.st[0], nx = b.st[1];
        if (nloc == 0u) { xcd_barrier_complete(bar, b.x, nloc, nx); b.st[0] = nloc; b.st[1] = nx; }
        const unsigned old = xb_add(&bar[XB_XSUB(b.x)], 1u);
        const unsigned gen = old / nloc;
        if (old + 1u == (gen + 1u) * nloc) {
            __builtin_amdgcn_fence(__ATOMIC_RELEASE, "agent");
            asm volatile("s_waitcnt vmcnt(0)" ::: "memory");
            const unsigned og = xb_add(&bar[XB_TOP], 1u);
            const unsigned tg = og / nx;
            if (og + 1u == (tg + 1u) * nx) xb_add(&bar[XB_TOPGEN], 1u);
            else XB_SPIN(xb_ld(&bar[XB_TOPGEN]) == tg, bar);
            __builtin_amdgcn_fence(__ATOMIC_ACQUIRE, "agent");
            xb_add(&bar[XB_XGEN(b.x)], 1u);
            asm volatile("s_waitcnt vmcnt(0)" ::: "memory");
        } else {
            XB_SPIN(xb_ld(&bar[XB_XGEN(b.x)]) == gen, bar);
            __builtin_amdgcn_fence(__ATOMIC_ACQUIRE, "agent");
            asm volatile("s_waitcnt vmcnt(0)" ::: "memory");
        }
    }
    __syncthreads();
}
constexpr int NWAVES = 8;
constexpr int RING_OFF = 0, RING_BYTES = 131072, LDSCTL_OFF = RING_BYTES, MISC_OFF = LDSCTL_OFF + 320, LDS_BYTES = 147456;
static_assert(att::L_END <= RING_BYTES, "attention LDS map");
constexpr int CW_BAR = 4096;
constexpr size_t CTL_ZERO_BYTES = 64 * 1024;
static_assert(WS_TA + 4097ull * 256 <= WS_TB && WS_TB + 4112ull * 256 <= WS_BT1 && WS_BT1 + 2304ull * 2048 <= WS_BT3 && WS_BT3 + 1024ull * 2048 <= WS_BT4 && WS_BT4 + 5632ull * 2048 <= WS_BT5 && WS_BT5 + 1024ull * 5632 <= WS_XB, "ws map 2");
static_assert(WS_STASH + 256ull * 8 * 64 * 64 * 4 <= WS_END, "stash");

struct Args { const float* in[18]; float* out; unsigned char* ws; RopeInv inv; int ph_lo, ph_hi; };
static_assert(sizeof(Args) == 18 * 8 + 8 + 8 + 192 + 8, "Args has no padding");

__device__ __forceinline__ float wave_sum_f(float v) {
#pragma unroll
    for (int o = 1; o < 64; o <<= 1) v += __shfl_xor(v, o);
    return v;
}
__device__ __forceinline__ void p0_transpose_item(const float* W, int K, int N, bf16_t* WT, int drow0, const float* gain, LAS float* scr, int kb, int n0, int lane) {
    const int k0 = 64 * kb;
#pragma unroll 8
    for (int i = 0; i < 32; ++i) { const int kk = 2 * i + (lane >> 5); scr[kk * 33 + (lane & 31)] = W[(size_t)(k0 + kk) * N + n0 + (lane & 31)] * (gain ? gain[k0 + kk] : 1.f); }
    LDS_WAIT(); asm volatile("" ::: "memory");
    const int c = lane & 7;
#pragma unroll
    for (int j = 0; j < 4; ++j) { const int n = (lane >> 3) + 8 * j; const LAS float* s = scr + (8 * c) * 33 + n;
        v4u o; o.x = pk2(s[0 * 33], s[1 * 33]); o.y = pk2(s[2 * 33], s[3 * 33]); o.z = pk2(s[4 * 33], s[5 * 33]); o.w = pk2(s[6 * 33], s[7 * 33]);
        *(GAS v4u*)(WT + (size_t)(drow0 + n) * K + k0 + 8 * c) = o; }
    LDS_WAIT(); asm volatile("" ::: "memory");
}

__device__ __forceinline__ void p0_prologue(const Args& A, LAS unsigned char* lds, int vcu, int G, int wave, int lane) {
    const float* x = A.in[0]; const float* meta = A.in[1]; const float* g1 = A.in[2]; const float* w_in = A.in[3]; const float* w_out = A.in[13]; const float* g2 = A.in[14];
    const float* w_gate = A.in[15]; const float* w_up = A.in[16]; const float* w_down = A.in[17];
    unsigned char* ws = A.ws;
    bf16_t *Bt1 = (bf16_t*)(ws + WS_BT1), *Bt3 = (bf16_t*)(ws + WS_BT3), *Bt4 = (bf16_t*)(ws + WS_BT4), *Bt5 = (bf16_t*)(ws + WS_BT5), *XB = (bf16_t*)(ws + WS_XB);
    float *ss = (float*)(ws + WS_RS), *ss2 = (float*)(ws + WS_SS), *TA = (float*)(ws + WS_TA), *TB = (float*)(ws + WS_TB);
    LAS float* scr = (LAS float*)(lds + RING_OFF + wave * 16384);
    const int gw = vcu * NWAVES + wave, NGW = G * NWAVES;
    constexpr int I_IN = 16 * 72, I_OUT = 16 * 32, I_G = 16 * 88, I_D = 44 * 32, NITEMS = I_IN + I_OUT + 2 * I_G + I_D;
    for (int it = gw; it < NITEMS; it += NGW) {
        int r = it;
        if (r < I_IN) { const int kb = r / 72, nb = r % 72, c0 = nb * 32; p0_transpose_item(w_in, 1024, 2304, Bt1, (c0 & ~255) + 128 * ((c0 & 63) >> 5) + 32 * ((c0 & 255) >> 6), g1, scr, kb, c0, lane); continue; } r -= I_IN;
        if (r < I_OUT) { const int kb = r / 32, nb = r % 32; p0_transpose_item(w_out, 1024, 1024, Bt3, nb * 32, nullptr, scr, kb, nb * 32, lane); continue; } r -= I_OUT;
        if (r < I_G) { const int kb = r / 88, nb = r % 88, f0 = nb * 32; p0_transpose_item(w_gate, 1024, 2816, Bt4, 256 * (f0 >> 7) + (f0 & 127), g2, scr, kb, f0, lane); continue; } r -= I_G;
        if (r < I_G) { const int kb = r / 88, nb = r % 88, f0 = nb * 32; p0_transpose_item(w_up, 1024, 2816, Bt4, 256 * (f0 >> 7) + 128 + (f0 & 127), g2, scr, kb, f0, lane); continue; } r -= I_G;
        { const int kb = r / 32, nb = r % 32; p0_transpose_item(w_down, 2816, 1024, Bt5, nb * 32, nullptr, scr, kb, nb * 32, lane); }
    }
    for (int m = gw; m < 33024; m += NGW) {
        GAS unsigned long long* o8 = (GAS unsigned long long*)(XB + (size_t)m * 1024) + lane;
        if (m < NTOK + NMETA) {
            const GAS f32x4* xr = (const GAS f32x4*)(m < NTOK ? x + (size_t)m * 1024 : meta + (size_t)(m - NTOK) * 1024) + lane;
            f32x4 v[4]; float s = 0.f;
#pragma unroll
            for (int j = 0; j < 4; ++j) { v[j] = xr[64 * j]; s += (v[j].x * v[j].x + v[j].y * v[j].y) + (v[j].z * v[j].z + v[j].w * v[j].w); }
            s = wave_sum_f(s);
#pragma unroll
            for (int j = 0; j < 4; ++j) o8[64 * j] = (unsigned long long)pk2(v[j].x, v[j].y) | ((unsigned long long)pk2(v[j].z, v[j].w) << 32);
            if (lane == 0) ss[m] = s;
        } else {
#pragma unroll
            for (int j = 0; j < 4; ++j) o8[64 * j] = 0ull;
            if (lane == 0) ss[m] = 1024.f;
        }
    }
    const int gt = gw * 64 + lane, NGT = NGW * 64;
    for (int p = gt; p < 4097 + 4112; p += NGT) {
        const bool isA = p < 4097; const int pos = isA ? p : p - 4097; float* dst = (isA ? TA : TB) + (size_t)pos * 64;
        for (int i = 0; i < 32; ++i) {
            float ang;
            if (isA) ang = pos == 4096 ? 0.f : (i < 16 ? (float)(pos >> 6) * A.inv.a[i] : (float)(pos & 63) * A.inv.a[i - 16]);
            else ang = (float)pos * A.inv.b[i];
            float c, s; rope_cs(ang, c, s); dst[2 * i] = c; dst[2 * i + 1] = s;
        }
    }
    if (gw < 4) ((float*)(ws + WS_GT))[gw * 64 + lane] = A.in[4 + gw][lane];
    for (int i = gt; i < NTOK; i += NGT) ss2[i] = 0.f;
    {   bf16_t *KA = (bf16_t*)(ws + WS_KA), *VA = (bf16_t*)(ws + WS_VA), *KB = (bf16_t*)(ws + WS_KB), *VB = (bf16_t*)(ws + WS_VB);
        const v4u z = (v4u){0u, 0u, 0u, 0u};
        for (int i = gt; i < (16 + 64) * 384; i += NGT) { const int g = i / 384, e = i % 384, c = e / 48, k = 16 + e % 48;
            bf16_t* base = g < 16 ? KA + (size_t)g * 65 * 4096 : KB + (size_t)(g - 16) * 65 * 4096; *(GAS v4u*)(base + c * 512 + k * 8) = z; }
        for (int i = gt; i < 16 * 2 * 192 + 32 * 4 * 192; i += NGT) {
            if (i < 16 * 2 * 192) { const int g = i / 384, e = i % 384, db = e / 192, q = e % 192; *(GAS v4u*)(VA + (size_t)g * 65 * 4096 + db * 2048 + 16 * 32 + q * 8) = z; }
            else { const int i2 = i - 16 * 2 * 192, g = i2 / 768, e = i2 % 768, db = e / 192, q = e % 192; *(GAS v4u*)(VB + (size_t)g * 65 * 8192 + db * 2048 + 16 * 32 + q * 8) = z; }
        }
    }
}

__global__ void __launch_bounds__(NWAVES * 64, 2) mega_fwd(Args args) {
    extern __shared__ __attribute__((aligned(16))) unsigned char lds_raw[];
    LAS unsigned char* lds = (LAS unsigned char*)lds_raw;
    volatile LAS unsigned* MISC = (volatile LAS unsigned*)(lds + MISC_OFF);
    const int tid = threadIdx.x, lane = tid & 63, wave = __builtin_amdgcn_readfirstlane(tid >> 6);
    const int G = gridDim.x; const int bx = blockIdx.x; const int vcu = (G % 8 == 0) ? (bx % 8) * (G / 8) + bx / 8 : bx;
    unsigned char* ws = args.ws;
    gu32* ctl = (gu32*)(ws + WS_CTL);
    for (int u = tid; u < (LDS_BYTES - LDSCTL_OFF) / 4; u += NWAVES * 64) ((LAS unsigned*)(lds + LDSCTL_OFF))[u] = 0u;
    __syncthreads();
    const int lo = args.ph_lo, hi = args.ph_hi;
    const bool multi = hi - lo > 1;
    XcdBarrier bar; bar.bar = (unsigned*)(ctl + CW_BAR); bar.x = 0; bar.st = nullptr;
    if (multi) bar = xcd_barrier_post((unsigned*)(ctl + CW_BAR), MISC + 8);
#ifndef PH_MASK
#define PH_MASK 63
#endif
#define IN(k) (((PH_MASK >> (k)) & 1) && lo <= (k) && (k) < hi)
#define SEAM(k) do { if (IN(k) && IN((k) + 1)) xcd_barrier(bar); } while (0)
    bf16_t *Bt1 = (bf16_t*)(ws + WS_BT1), *Bt3 = (bf16_t*)(ws + WS_BT3), *Bt4 = (bf16_t*)(ws + WS_BT4), *Bt5 = (bf16_t*)(ws + WS_BT5), *XB = (bf16_t*)(ws + WS_XB);
    bf16_t *QA = (bf16_t*)(ws + WS_QA), *QB = (bf16_t*)(ws + WS_QB), *KA = (bf16_t*)(ws + WS_KA), *VA = (bf16_t*)(ws + WS_VA), *KB = (bf16_t*)(ws + WS_KB), *VB = (bf16_t*)(ws + WS_VB);
    bf16_t *MIX = (bf16_t*)(ws + WS_MIX), *X1B = (bf16_t*)(ws + WS_X1B), *HID = (bf16_t*)(ws + WS_HID);
    float *ss = (float*)(ws + WS_RS), *ss2 = (float*)(ws + WS_SS), *TA = (float*)(ws + WS_TA), *TB = (float*)(ws + WS_TB);

    if (IN(0)) { p0_prologue(args, lds, vcu, G, wave, lane); SEAM(0); }
    if (IN(1)) {
        pg8::Gemm g{XB, Bt1, 33024, 2304, 1024}; pg8::StaticOrder S; S.init(33024, 2304, G, bx);
        pg8::EpiProj E{ss, (const float*)(ws + WS_GT), TA, (bf16_t*)ws};
        pg8::gemm_phase<pg8::EpiProj, pg8::StaticOrder, true, true>(lds + RING_OFF, g, S, E);
        SEAM(1);
    }
    if (IN(2)) {
        att::Tensors T{QA, QB, KA, VA, KB, VB, MIX, (float*)(ws + WS_STASH), args.in[4], args.in[5], args.in[6], args.in[7], args.in[8], args.in[9], args.in[10], args.in[11], args.in[12]};
        att::phase((att::lds_ptr)(lds + RING_OFF), T, vcu, G);
        SEAM(2);
    }
    if (IN(3)) {
        pg8::Gemm g{MIX, Bt3, 32768, 1024, 1024}; pg8::StaticOrder S; S.init(32768, 1024, G, bx);
        pg8::EpiRes1 E{args.in[0], args.out, X1B, ss2};
        pg8::gemm_phase<pg8::EpiRes1, pg8::StaticOrder, true, true>(lds + RING_OFF, g, S, E);
        SEAM(3);
    }
    if (IN(4)) {
        pg8::Gemm g{X1B, Bt4, 32768, 5632, 1024}; pg8::StaticOrder S; S.init(32768, 5632, G, bx);
        pg8::EpiSwiglu E{ss2, HID};
        pg8::gemm_phase<pg8::EpiSwiglu, pg8::StaticOrder, true, true>(lds + RING_OFF, g, S, E);
        SEAM(4);
    }
    if (IN(5)) {
        pg8::Gemm g{HID, Bt5, 32768, 1024, 2816}; pg8::StaticOrder S; S.init(32768, 1024, G, bx);
        pg8::EpiRes2 E{args.out};
        pg8::gemm_phase<pg8::EpiRes2, pg8::StaticOrder, true, true>(lds + RING_OFF, g, S, E);
    }
#undef IN
#undef SEAM
}
#ifndef OPT_MASK
#define OPT_MASK 31
#endif
#ifndef FUSED
#define FUSED 0
#endif
extern "C" void kernel_launch(void* const* d_in, const int* in_sizes, int n_in, void* d_out, int out_size, void* d_ws, size_t ws_size, hipStream_t stream) {
    const float* x = (const float*)d_in[0]; const float* meta = (const float*)d_in[1]; const float* g1 = (const float*)d_in[2]; const float* w_in = (const float*)d_in[3];
    const float* gqa = (const float*)d_in[4]; const float* gka = (const float*)d_in[5]; const float* gqb = (const float*)d_in[6]; const float* gkb = (const float*)d_in[7];
    const float* lq1 = (const float*)d_in[8]; const float* lk1 = (const float*)d_in[9]; const float* lq2 = (const float*)d_in[10]; const float* lk2 = (const float*)d_in[11];
    const float* subg = (const float*)d_in[12]; const float* w_out = (const float*)d_in[13]; const float* g2 = (const float*)d_in[14];
    const float* w_gate = (const float*)d_in[15]; const float* w_up = (const float*)d_in[16]; const float* w_down = (const float*)d_in[17];
    float* out = (float*)d_out; unsigned char* ws = (unsigned char*)d_ws;
    if (n_in != 18 || ws_size < WS_END || out_size != NTOK * DM) { fprintf(stderr, "kernel_launch: unexpected shapes (n_in %d, ws %zu, out %d)\n", n_in, ws_size, out_size); return; }
    float* rs = (float*)(ws + WS_RS); float* ss2 = (float*)(ws + WS_SS);
    bf16_t *QA = (bf16_t*)(ws + WS_QA), *QB = (bf16_t*)(ws + WS_QB), *KA = (bf16_t*)(ws + WS_KA), *VA = (bf16_t*)(ws + WS_VA), *KB = (bf16_t*)(ws + WS_KB), *VB = (bf16_t*)(ws + WS_VB);
    bf16_t *MIX = (bf16_t*)(ws + WS_MIX), *X1B = (bf16_t*)(ws + WS_X1B), *HID = (bf16_t*)(ws + WS_HID);
    float* projf = (float*)(ws + WS_PROJF); float* OA = (float*)(ws + WS_NAIVE); float* OB = OA + (size_t)64 * SEQ * 64;
    RopeInv inv;
    for (int i = 0; i < 16; ++i) inv.a[i] = (float)pow(10000.0, -(double)(2 * i) / 32.0);
    for (int i = 0; i < 32; ++i) inv.b[i] = (float)pow(10000.0, -(double)(2 * i) / 64.0);
    static int grid = 0;
    if (grid == 0) {
        int dev = 0, cus = 0, per_cu = 0;
        if (hipGetDevice(&dev) != hipSuccess || hipDeviceGetAttribute(&cus, hipDeviceAttributeMultiprocessorCount, dev) != hipSuccess) { fprintf(stderr, "kernel_launch: device query failed\n"); grid = -1; return; }
        if (hipFuncSetAttribute((const void*)mega_fwd, hipFuncAttributeMaxDynamicSharedMemorySize, LDS_BYTES) != hipSuccess) { fprintf(stderr, "kernel_launch: hipFuncSetAttribute failed\n"); grid = -1; return; }
        if (hipOccupancyMaxActiveBlocksPerMultiprocessor(&per_cu, (const void*)mega_fwd, NWAVES * 64, LDS_BYTES) != hipSuccess || per_cu < 1) { fprintf(stderr, "kernel_launch: occupancy query says %d blocks/CU\n", per_cu); per_cu = 1; }
        (void)hipGetLastError();
        grid = cus * 1;
    }
    if (grid < 0) return;
    Args a{};
    for (int i = 0; i < 18; ++i) a.in[i] = (const float*)d_in[i];
    a.out = out; a.ws = ws; a.inv = inv;
    const int NR = NTOK + NMETA;
    if (OPT_MASK) (void)hipMemsetAsync(ws + WS_CTL, 0, CTL_ZERO_BYTES, stream);
#define MEGA(lo_, hi_) do { a.ph_lo = (lo_); a.ph_hi = (hi_); hipLaunchKernelGGL(mega_fwd, dim3(grid), dim3(NWAVES * 64), LDS_BYTES, stream, a); } while (0)
    if (FUSED && OPT_MASK == 31) { MEGA(0, 6); return; }
    if (OPT_MASK) MEGA(0, 1);
    if (OPT_MASK & 1) MEGA(1, 2);
    else {
        nk_rowss<<<(NR + 3) / 4, 256, 0, stream>>>(x, meta, rs, NR);
        nk_zero_pads<<<(112 * 48 * 128) / 256, 256, 0, stream>>>(KA, VA, KB, VB);
        for (int half = 0; half < 2; ++half) {
            nk_gemm<1, AL1, WL1, EP1><<<dim3(18, (NR + 63) / 64), 256, 0, stream>>>(NR, 1152, DM, AL1{x, meta, rs, g1}, WL1{w_in, half * 1152}, EP1{projf});
            nk_epi1<<<(NR * 18 + 255) / 256, 256, 0, stream>>>(projf, half * 18, inv, gqa, gka, gqb, gkb, QA, KA, VA, QB, KB, VB);
        }
    }
    if (OPT_MASK & 2) MEGA(2, 3);
    else {
        nk_attn<<<dim3(16, 64), 256, 0, stream>>>(QA, KA, VA, OA, gqa, gka, 0);
        nk_attn<<<dim3(16, 128), 256, 0, stream>>>(QB, KB, VB, OB, gqb, gkb, 1);
        nk_mix<<<(NTOK * 12 + 255) / 256, 256, 0, stream>>>(OA, OB, MIX, lq1, lk1, lq2, lk2, subg);
    }
    if (OPT_MASK & 4) MEGA(3, 4);
    else {
        nk_gemm<1, AL3, WLp, EP3><<<dim3(16, NTOK / 64), 256, 0, stream>>>(NTOK, DM, DM, AL3{MIX, DM}, WLp{w_out, DM}, EP3{x, out, X1B});
        nk_rowss<<<NTOK / 4, 256, 0, stream>>>(out, nullptr, ss2, NTOK);
    }
    if (OPT_MASK & 8) MEGA(4, 5);
    else nk_gemm<2, AL4, WL4, EP4><<<dim3(DFF / 64, NTOK / 64), 256, 0, stream>>>(NTOK, DFF, DM, AL4{out, ss2, g2}, WL4{w_gate, w_up}, EP4{HID});
    if (OPT_MASK & 16) MEGA(5, 6);
    else nk_gemm<1, AL3, WLp, EP5><<<dim3(16, NTOK / 64), 256, 0, stream>>>(NTOK, DM, DFF, AL3{HID, DFF}, WLp{w_down, DM}, EP5{out});
#undef MEGA
}
```

```cpp
#include <hip/hip_runtime.h>
#include <cstdint>
#include <cstdio>
#include <cmath>

typedef unsigned short bf16_t;
namespace cfg {
constexpr int NB = 8, SEQ = 4096, NMETA = 16, DM = 1024, NTOK = NB * SEQ;
constexpr int INW = 2304, DFF = 2816, NT_KV = 65;
constexpr float EPS = 1e-6f, LOG2E = 1.4426950408889634f, C2 = 0.125f * LOG2E;
constexpr float LAM_INIT = 0.2f;
constexpr size_t MiB = 1u << 20;
constexpr size_t WS_CTL = 0, WS_RS = 1 * MiB, WS_SS = 1 * MiB + 256 * 1024;
constexpr size_t WS_GT = 1 * MiB + 448 * 1024;
constexpr size_t WS_TA = 2 * MiB, WS_TB = 4 * MiB, WS_BT1 = 6 * MiB, WS_BT3 = 11 * MiB, WS_BT4 = 13 * MiB, WS_BT5 = 24 * MiB;
constexpr size_t WS_XB = 32 * MiB;
constexpr size_t WS_QA = WS_XB + 33024ull * 2048;
constexpr size_t WS_QB = WS_QA + 32 * MiB;
constexpr size_t WS_KA = WS_QB + 32 * MiB;
constexpr size_t WS_VA = WS_KA + 16ull * NT_KV * 8192;
constexpr size_t WS_KB = WS_VA + 16ull * NT_KV * 8192;
constexpr size_t WS_VB = WS_KB + 64ull * NT_KV * 8192;
constexpr size_t WS_REND = WS_VB + 32ull * NT_KV * 16384;
constexpr size_t WS_HID = 32 * MiB;
constexpr size_t WS_MIX = 242 * MiB, WS_X1B = 306 * MiB, WS_STASH = 370 * MiB, WS_NAIVE = 306 * MiB, WS_PROJF = 242 * MiB, WS_END = 512 * MiB;
static_assert(WS_REND <= WS_MIX && WS_HID + 32768ull * DFF * 2 <= WS_MIX, "ws map");
}
using namespace cfg;

__host__ __device__ __forceinline__ unsigned f2bf(float f) { unsigned u = __builtin_bit_cast(unsigned, f); return (u + 0x7fffu + ((u >> 16) & 1u)) >> 16; }
__host__ __device__ __forceinline__ float bf2f(bf16_t h) { return __builtin_bit_cast(float, (unsigned)h << 16); }
__host__ __device__ __forceinline__ size_t kidx(int grp, int krow, int d) { return ((size_t)grp * NT_KV + (krow >> 6)) * 4096 + (d >> 3) * 512 + (krow & 63) * 8 + (d & 7); }
__host__ __device__ __forceinline__ size_t vidx(int grp, int krow, int d, int ndb) { return ((size_t)grp * NT_KV + (krow >> 6)) * (size_t)(ndb * 2048) + (d >> 5) * 2048 + (krow & 63) * 32 + (d & 31); }

struct RopeInv { float a[16]; float b[32]; };
__device__ __forceinline__ void rope_cs(float ang, float& c, float& s) {
    double rev = (double)ang * 0.15915494309189535; rev -= floor(rev); const float r = (float)rev;
    c = __builtin_amdgcn_cosf(r); s = __builtin_amdgcn_sinf(r);
}

__global__ void __launch_bounds__(256) nk_rowss(const float* x, const float* meta, float* ss, int nrows) {
    const int row = blockIdx.x * 4 + (threadIdx.x >> 6), lane = threadIdx.x & 63;
    if (row >= nrows) return;
    const float* p = row < NTOK ? x + (size_t)row * DM : meta + (size_t)(row - NTOK) * DM;
    float s = 0.f;
    for (int i = lane; i < DM; i += 64) { const float v = p[i]; s += v * v; }
    for (int o = 1; o < 64; o <<= 1) s += __shfl_xor(s, o);
    if (lane == 0) ss[row] = s;
}

template <int NW, class AL, class WL, class EP>
__global__ void __launch_bounds__(256) nk_gemm(int M, int N, int K, AL al, WL wl, EP ep) {
    __shared__ float As[16][68];
    __shared__ float Ws[NW][16][68];
    const int tid = threadIdx.x, tx = tid & 15, ty = tid >> 4, m0 = blockIdx.y * 64, n0 = blockIdx.x * 64;
    float acc[NW][4][4];
#pragma unroll
    for (int w = 0; w < NW; ++w)
#pragma unroll
        for (int i = 0; i < 4; ++i)
#pragma unroll
            for (int j = 0; j < 4; ++j) acc[w][i][j] = 0.f;
    for (int k0 = 0; k0 < K; k0 += 16) {
#pragma unroll
        for (int i = 0; i < 4; ++i) { const int e = tid + i * 256, r = e >> 4, kk = e & 15, row = m0 + r; As[kk][r] = row < M ? al(row, k0 + kk) : 0.f; }
#pragma unroll
        for (int w = 0; w < NW; ++w)
#pragma unroll
            for (int i = 0; i < 4; ++i) { const int e = tid + i * 256, kk = e >> 6, c = e & 63; Ws[w][kk][c] = wl(w, k0 + kk, n0 + c); }
        __syncthreads();
#pragma unroll
        for (int kk = 0; kk < 16; ++kk) {
            float a[4];
#pragma unroll
            for (int i = 0; i < 4; ++i) a[i] = As[kk][ty * 4 + i];
#pragma unroll
            for (int w = 0; w < NW; ++w) {
                float b[4];
#pragma unroll
                for (int j = 0; j < 4; ++j) b[j] = Ws[w][kk][tx * 4 + j];
#pragma unroll
                for (int i = 0; i < 4; ++i)
#pragma unroll
                    for (int j = 0; j < 4; ++j) acc[w][i][j] += a[i] * b[j];
            }
        }
        __syncthreads();
    }
#pragma unroll
    for (int i = 0; i < 4; ++i)
#pragma unroll
        for (int j = 0; j < 4; ++j) { const int row = m0 + ty * 4 + i, col = n0 + tx * 4 + j; if (row < M) ep(row, col, acc[0][i][j], NW > 1 ? acc[NW - 1][i][j] : 0.f); }
}

struct AL1 { const float* x; const float* meta; const float* ss; const float* g; __device__ float operator()(int row, int k) const {
    const float v = row < NTOK ? x[(size_t)row * DM + k] : meta[(size_t)(row - NTOK) * DM + k]; return v * rsqrtf(ss[row] * (1.f / DM) + EPS) * g[k]; } };
struct WL1 { const float* w; int coloff; int pad; __device__ float operator()(int, int k, int col) const { return w[(size_t)k * INW + coloff + col]; } };
struct EP1 { float* o; __device__ void operator()(int row, int col, float v, float) const { o[(size_t)row * 1152 + col] = v; } };

__global__ void __launch_bounds__(256) nk_epi1(const float* projf, int slot0, RopeInv inv, const float* gqa, const float* gka, const float* gqb, const float* gkb,
                                               bf16_t* QA, bf16_t* KA, bf16_t* VA, bf16_t* QB, bf16_t* KB, bf16_t* VB) {
    const int idx = blockIdx.x * 256 + threadIdx.x; const int row = idx / 18, sl = idx % 18, slot = slot0 + sl;
    if (row >= NTOK + NMETA) return;
    const bool meta = row >= NTOK; const int m = row - NTOK, b = row / SEQ, t = row % SEQ;
    const float* v = projf + (size_t)row * 1152 + sl * 64;
    int type, hh;
    if (slot < 8) { type = 0; hh = slot; } else if (slot < 10) { type = 1; hh = slot - 8; } else if (slot < 12) { type = 2; hh = slot - 10; }
    else if (slot < 20) { type = 3; hh = slot - 12; } else if (slot < 28) { type = 4; hh = slot - 20; } else { type = 5; hh = slot - 28; }
    if (meta && (type == 0 || type == 3)) return;
    const bool isB = type >= 3, normed = (type != 2 && type != 5);
    const float* g = type == 0 ? gqa : type == 1 ? gka : type == 3 ? gqb : gkb;
    float rn = 1.f;
    if (normed) { float ss = 0.f; for (int d = 0; d < 64; ++d) ss += v[d] * v[d]; rn = rsqrtf(ss * (1.f / 64.f) + EPS); }
    for (int i = 0; i < 32; ++i) {
        float x1 = v[2 * i], x2 = v[2 * i + 1];
        if (normed) {
            x1 *= rn * g[2 * i]; x2 *= rn * g[2 * i + 1];
            float ang;
            if (!isB) ang = meta ? 0.f : (i < 16 ? (float)(t >> 6) * inv.a[i] : (float)(t & 63) * inv.a[i - 16]);
            else ang = (float)(meta ? m : NMETA + t) * inv.b[i];
            float c, s; rope_cs(ang, c, s);
            const float y1 = x1 * c - x2 * s, y2 = x1 * s + x2 * c; x1 = y1; x2 = y2;
            if (type == 0 || type == 3) { x1 *= C2; x2 *= C2; }
        }
        const bf16_t o1 = (bf16_t)f2bf(x1), o2 = (bf16_t)f2bf(x2); const int d = 2 * i;
        const int krow = meta ? m : 64 + t;
        for (int bb = (meta ? 0 : b); bb < (meta ? NB : b + 1); ++bb) {
            if (type == 0) { bf16_t* p = QA + ((size_t)(bb * 8 + hh) * SEQ + t) * 64 + d; p[0] = o1; p[1] = o2; }
            else if (type == 3) { bf16_t* p = QB + ((size_t)(bb * 8 + hh) * SEQ + t) * 64 + d; p[0] = o1; p[1] = o2; }
            else if (type == 1) { KA[kidx(bb * 2 + hh, krow, d)] = o1; KA[kidx(bb * 2 + hh, krow, d + 1)] = o2; }
            else if (type == 4) { KB[kidx(bb * 8 + hh, krow, d)] = o1; KB[kidx(bb * 8 + hh, krow, d + 1)] = o2; }
            else if (type == 2) { VA[vidx(bb * 2 + hh, krow, d, 2)] = o1; VA[vidx(bb * 2 + hh, krow, d + 1, 2)] = o2; }
            else { const int hb = hh >> 1, dd = (hh & 1) * 64 + d; VB[vidx(bb * 4 + hb, krow, dd, 4)] = o1; VB[vidx(bb * 4 + hb, krow, dd + 1, 4)] = o2; }
        }
    }
}

__global__ void __launch_bounds__(256) nk_zero_pads(bf16_t* KA, bf16_t* VA, bf16_t* KB, bf16_t* VB) {
    const int idx = blockIdx.x * 256 + threadIdx.x;
    const int d = idx & 127, kr = 16 + ((idx >> 7) % 48), g = idx / (128 * 48);
    if (g < 16) { if (d < 64) { KA[kidx(g, kr, d)] = 0; VA[vidx(g, kr, d, 2)] = 0; } }
    else if (g < 16 + 64) { if (d < 64) KB[kidx(g - 16, kr, d)] = 0; }
    else if (g < 16 + 64 + 32) VB[vidx(g - 80, kr, d, 4)] = 0;
}

__global__ void __launch_bounds__(256) nk_attn(const bf16_t* Q, const bf16_t* K, const bf16_t* V, float* O, const float* gq, const float* gk, int mode) {
    __shared__ float Ks[64][64];
    __shared__ float Vs[64][64];
    const int tid = threadIdx.x, u = blockIdx.y, q = blockIdx.x * 256 + tid;
    int qu, kgrp, vgrp, ndb, dboff;
    if (mode == 0) { const int b = u >> 3, h = u & 7; qu = u; kgrp = b * 2 + (h >> 2); vgrp = kgrp; ndb = 2; dboff = 0; }
    else { const int dh = u & 1, bs = u >> 1, b = bs >> 3, sh = bs & 7; qu = bs; kgrp = bs; vgrp = b * 4 + (sh >> 1); ndb = 4; dboff = 64 * dh; }
    float mq = 0.f, mk = 0.f;
    for (int d = 0; d < 64; ++d) { mq = fmaxf(mq, fabsf(gq[d])); mk = fmaxf(mk, fabsf(gk[d])); }
    const float Mc = 8.f * mq * mk * LOG2E;
    float qv[64], o[64]; float l = 0.f;
    const bf16_t* qp = Q + ((size_t)qu * SEQ + q) * 64;
#pragma unroll
    for (int d = 0; d < 64; ++d) { qv[d] = bf2f(qp[d]); o[d] = 0.f; }
    for (int tile = 0; tile < NT_KV; ++tile) {
        for (int i = 0; i < 16; ++i) { const int e = tid * 16 + i, key = e >> 6, d = e & 63;
            Ks[key][d] = bf2f(K[kidx(kgrp, tile * 64 + key, d)]); Vs[key][d] = bf2f(V[vidx(vgrp, tile * 64 + key, dboff + d, ndb)]); }
        __syncthreads();
        const int nk = tile == 0 ? NMETA : 64;
        for (int key = 0; key < nk; ++key) {
            float s = -Mc;
#pragma unroll
            for (int d = 0; d < 64; ++d) s += qv[d] * Ks[key][d];
            const float p = exp2f(s); l += p;
#pragma unroll
            for (int d = 0; d < 64; ++d) o[d] += p * Vs[key][d];
        }
        __syncthreads();
    }
    const float il = 1.f / l; float* op = O + ((size_t)u * SEQ + q) * 64;
#pragma unroll
    for (int d = 0; d < 64; ++d) op[d] = o[d] * il;
}

__global__ void __launch_bounds__(256) nk_mix(const float* OA, const float* OB, bf16_t* MIX, const float* lq1, const float* lk1, const float* lq2, const float* lk2, const float* subg) {
    const int idx = blockIdx.x * 256 + threadIdx.x; const int row = idx / 12, part = idx % 12;
    if (row >= NTOK) return;
    const int b = row / SEQ, t = row % SEQ;
    if (part < 8) { const float* s = OA + ((size_t)(b * 8 + part) * SEQ + t) * 64; bf16_t* d = MIX + (size_t)row * DM + part * 64; for (int i = 0; i < 64; ++i) d[i] = (bf16_t)f2bf(s[i]); return; }
    const int hb = part - 8;
    float s1 = 0.f, s2 = 0.f; for (int i = 0; i < 64; ++i) { s1 += lq1[i] * lk1[i]; s2 += lq2[i] * lk2[i]; }
    const float lam = expf(s1) - expf(s2) + LAM_INIT;
    const float* o0 = OB + ((size_t)((b * 8 + 2 * hb) * 2) * SEQ) * 64;
    const float* o1 = OB + ((size_t)((b * 8 + 2 * hb + 1) * 2) * SEQ) * 64;
    float ss = 0.f;
    for (int d = 0; d < 128; ++d) { const size_t off = ((size_t)(d >> 6) * SEQ + t) * 64 + (d & 63); const float v = o0[off] - lam * o1[off]; ss += v * v; }
    const float rn = rsqrtf(ss * (1.f / 128.f) + EPS) * (1.f - LAM_INIT);
    bf16_t* dst = MIX + (size_t)row * DM + 512 + hb * 128;
    for (int d = 0; d < 128; ++d) { const size_t off = ((size_t)(d >> 6) * SEQ + t) * 64 + (d & 63); const float v = o0[off] - lam * o1[off]; dst[d] = (bf16_t)f2bf(v * rn * subg[d]); }
}

struct AL3 { const bf16_t* a; int lda; int pad; __device__ float operator()(int row, int k) const { return bf2f(a[(size_t)row * lda + k]); } };
struct WLp { const float* w; int ldw; int pad; __device__ float operator()(int, int k, int col) const { return w[(size_t)k * ldw + col]; } };
struct EP3 { const float* x; float* x1; bf16_t* x1b; __device__ void operator()(int row, int col, float v, float) const { const size_t o = (size_t)row * DM + col; const float r = x[o] + v; x1[o] = r; x1b[o] = (bf16_t)f2bf(r); } };
struct AL4 { const float* x1; const float* ss; const float* g; __device__ float operator()(int row, int k) const { return x1[(size_t)row * DM + k] * rsqrtf(ss[row] * (1.f / DM) + EPS) * g[k]; } };
struct WL4 { const float* wg; const float* wu; __device__ float operator()(int w, int k, int col) const { return (w ? wu : wg)[(size_t)k * DFF + col]; } };
struct EP4 { bf16_t* hid; __device__ void operator()(int row, int col, float g, float u) const { const float s = g / (1.f + __expf(-g)); hid[(size_t)row * DFF + col] = (bf16_t)f2bf(s * u); } };
struct EP5 { float* out; __device__ void operator()(int row, int col, float v, float) const { out[(size_t)row * DM + col] += v; } };

namespace pg8 {
#define PG8_LAS __attribute__((address_space(3)))
typedef unsigned short bf16_t;
typedef short bf16x8 __attribute__((ext_vector_type(8)));
typedef float f32x4 __attribute__((ext_vector_type(4)));
typedef unsigned u32x4 __attribute__((ext_vector_type(4)));
constexpr int BM = 256, BK = 64, HALF = 128, HTB = HALF * BK * 2  , STAGE_BYTES = 8 * HTB, NXCD = 8, WGM = 8;

__host__ __device__ __forceinline__ int lds_byte(int r, int c) { const int st = (r >> 4) * 2 + (c >> 5), rr = r & 15, cc = c & 31, ob = rr * 64 + cc * 2; return st * 1024 + (ob ^ (((ob >> 9) & 1) << 5)); }
__host__ __device__ __forceinline__ void stage_rc(int b, int& R, int& C) { const int st = b / 1024, sb = b % 1024, swz = sb ^ (((sb >> 9) & 1) << 5); R = (st >> 1) * 16 + swz / 64; C = (st & 1) * 32 + (swz % 64) / 2; }
__host__ __device__ __forceinline__ int perm32(int rho) { const int n = rho >> 4, i = rho & 15; return 8 * (i >> 2) + 4 * n + (i & 3); }

struct Unit { int pm, pn; };
struct Gemm { const bf16_t* A; const bf16_t* Bt; int M, N, K; };

struct StaticOrder {
    int nM, nN, nwg, G, c;
    __host__ __device__ void init(int M, int N, int G_, int c_) { nM = M / BM; nN = N / BM; nwg = nM * nN; G = G_; c = c_; }
    __host__ __device__ bool next(int i, Unit& u) const {
        const long L = (long)i * G + c; if (L >= nwg) return false;
        int wgid = (int)L; { const int q = nwg / NXCD, r = nwg % NXCD, xcd = wgid % NXCD, off = wgid / NXCD; wgid = (xcd < r ? xcd * (q + 1) : r * (q + 1) + (xcd - r) * q) + off; }
        const int nig = WGM * nN, gid = wgid / nig, fm = gid * WGM, gsz = (nM - fm) < WGM ? (nM - fm) : WGM;
        u.pm = fm + ((wgid % nig) % gsz); u.pn = (wgid % nig) / gsz; return true;
    }
    __device__ __forceinline__ void a_ready(const Unit&) const {}
    __device__ __forceinline__ void done(const Unit&) const {}
};

__device__ __forceinline__ unsigned cvt_pk_bf16(float lo, float hi) { unsigned r; asm volatile("v_cvt_pk_bf16_f32 %0, %1, %2" : "=v"(r) : "v"(lo), "v"(hi)); return r; }

struct EpiProj {
    static constexpr bool PERM = true, AFTER_DRAIN = false;
    const float* ss; const float* GT; const float* TAB; bf16_t* wsb;
    static constexpr size_t TBOFF = (WS_TB - WS_TA) / 4, O_QA = WS_QA / 2, O_QB = WS_QB / 2, O_KA = WS_KA / 2, O_VA = WS_VA / 2, O_KB = WS_KB / 2, O_VB = WS_VB / 2;
    __device__ __forceinline__ void operator()(const f32x4 (&acc)[2][2][4][2], const Unit& u, int wr, int wc, int fr_, int fq_) const {
        int fr = fr_, fq = fq_; asm volatile("" : "+v"(fr), "+v"(fq));
        const int slot = u.pn * 4 + wc; const bool metaT = (u.pm == 128);
        int type, hh;
        if (slot < 8) { type = 0; hh = slot; } else if (slot < 10) { type = 1; hh = slot - 8; } else if (slot < 12) { type = 2; hh = slot - 10; }
        else if (slot < 20) { type = 3; hh = slot - 12; } else if (slot < 28) { type = 4; hh = slot - 20; } else { type = 5; hh = slot - 28; }
        if (metaT && (type == 0 || type == 3)) return;
        const bool isB = type >= 3, normed = (type != 2 && type != 5), isQ = (type == 0 || type == 3);
        const int gi = type == 0 ? 0 : type == 1 ? 1 : type == 3 ? 2 : 3;
        f32x4 gv[2][2];
#pragma unroll
        for (int bj = 0; bj < 2; ++bj)
#pragma unroll
            for (int n = 0; n < 2; ++n) gv[bj][n] = *(const f32x4*)(GT + gi * 64 + 32 * bj + 8 * fq + 4 * n);
        const int b = u.pm >> 4, tbase = (u.pm & 15) * 256;
        size_t obase, bstride; int tilesz;
        if (type == 0)      { obase = O_QA + (size_t)hh * 4096 * 64; bstride = (size_t)8 * 4096 * 64; tilesz = 0; }
        else if (type == 3) { obase = O_QB + (size_t)hh * 4096 * 64; bstride = (size_t)8 * 4096 * 64; tilesz = 0; }
        else if (type == 1) { obase = O_KA + (size_t)hh * 65 * 4096; bstride = (size_t)2 * 65 * 4096; tilesz = 4096; }
        else if (type == 4) { obase = O_KB + (size_t)hh * 65 * 4096; bstride = (size_t)8 * 65 * 4096; tilesz = 4096; }
        else if (type == 2) { obase = O_VA + (size_t)hh * 65 * 4096; bstride = (size_t)2 * 65 * 4096; tilesz = 4096; }
        else                { obase = O_VB + (size_t)(hh >> 1) * 65 * 8192 + (size_t)((hh & 1) * 2) * 2048; bstride = (size_t)4 * 65 * 8192; tilesz = 8192; }
        const bool isK = (type == 1 || type == 4);
#pragma unroll
        for (int ai = 0; ai < 2; ++ai)
#pragma unroll
            for (int m = 0; m < 4; ++m) {
                if (metaT && (ai | m | wr)) continue;
                const int rloc = ai * 128 + wr * 64 + m * 16 + fr, row = u.pm * 256 + rloc, t = tbase + rloc;
                const float rsx = __builtin_amdgcn_rsqf(ss[row] * (1.f / 1024.f) + 1e-6f);
                f32x4 y[2][2]; float s = 0.f;
#pragma unroll
                for (int bj = 0; bj < 2; ++bj)
#pragma unroll
                    for (int n = 0; n < 2; ++n) { y[bj][n] = acc[ai][bj][m][n] * rsx; const f32x4 q = y[bj][n] * y[bj][n]; s += (q[0] + q[1]) + (q[2] + q[3]); }
                if (normed) {
                    s += __shfl_xor(s, 16); s += __shfl_xor(s, 32);
                    const float rn = __builtin_amdgcn_rsqf(s * (1.f / 64.f) + 1e-6f) * (isQ ? 0.18033688011112042f : 1.f);
                    const float* T = TAB + (isB ? TBOFF + (size_t)(metaT ? rloc : 16 + t) * 64 : (size_t)(metaT ? 4096 : t) * 64);
#pragma unroll
                    for (int bj = 0; bj < 2; ++bj)
#pragma unroll
                        for (int n = 0; n < 2; ++n) {
                            const f32x4 cs = *(const f32x4*)(T + (16 * bj + 4 * fq + 2 * n) * 2);
                            const f32x4 v = y[bj][n] * gv[bj][n] * rn;
                            y[bj][n] = (f32x4){v[0] * cs[0] - v[1] * cs[1], v[0] * cs[1] + v[1] * cs[0], v[2] * cs[2] - v[3] * cs[3], v[2] * cs[3] + v[3] * cs[2]};
                        }
                }
                u32x4 w[2];
#pragma unroll
                for (int bj = 0; bj < 2; ++bj) { w[bj].x = cvt_pk_bf16(y[bj][0][0], y[bj][0][1]); w[bj].y = cvt_pk_bf16(y[bj][0][2], y[bj][0][3]); w[bj].z = cvt_pk_bf16(y[bj][1][0], y[bj][1][1]); w[bj].w = cvt_pk_bf16(y[bj][1][2], y[bj][1][3]); }
                size_t off; int step;
                if (isQ) { off = (size_t)t * 64 + 8 * fq; step = 32; }
                else { const int krow = metaT ? rloc : 64 + t, tile = krow >> 6, key = krow & 63;
                    if (isK) { off = (size_t)tile * tilesz + fq * 512 + key * 8; step = 2048; } else { off = (size_t)tile * tilesz + key * 32 + 8 * fq; step = 2048; } }
                for (int bb = (metaT ? 0 : b); bb < (metaT ? 8 : b + 1); ++bb) { bf16_t* p = wsb + obase + (size_t)bb * bstride + off; *(u32x4*)(p) = w[0]; *(u32x4*)(p + step) = w[1]; }
                asm volatile("" ::: "memory");
            }
    }
};

struct EpiRes1 {
    static constexpr bool PERM = true, AFTER_DRAIN = false;
    const float* x; float* out; bf16_t* x1b; float* ss2;
    __device__ __forceinline__ void operator()(const f32x4 (&acc)[2][2][4][2], const Unit& u, int wr, int wc, int fr, int fq) const {
#pragma unroll
        for (int ai = 0; ai < 2; ++ai)
#pragma unroll
            for (int m = 0; m < 4; ++m) {
                const int row = u.pm * 256 + ai * 128 + wr * 64 + m * 16 + fr; float s = 0.f;
#pragma unroll
                for (int bj = 0; bj < 2; ++bj) {
                    const size_t off = (size_t)row * 1024 + u.pn * 256 + bj * 128 + wc * 32 + 8 * fq;
                    const f32x4 a0 = *(const f32x4*)(x + off) + acc[ai][bj][m][0], a1 = *(const f32x4*)(x + off + 4) + acc[ai][bj][m][1];
                    *(f32x4*)(out + off) = a0; *(f32x4*)(out + off + 4) = a1;
                    u32x4 w; w.x = cvt_pk_bf16(a0[0], a0[1]); w.y = cvt_pk_bf16(a0[2], a0[3]); w.z = cvt_pk_bf16(a1[0], a1[1]); w.w = cvt_pk_bf16(a1[2], a1[3]);
                    *(u32x4*)(x1b + off) = w;
                    const f32x4 q0 = a0 * a0, q1 = a1 * a1; s += ((q0[0] + q0[1]) + (q0[2] + q0[3])) + ((q1[0] + q1[1]) + (q1[2] + q1[3]));
                }
                s += __shfl_xor(s, 16); s += __shfl_xor(s, 32);
                if (fq == 0) atomicAdd(ss2 + row, s);
            }
    }
};

struct EpiSwiglu {
    static constexpr bool PERM = true, AFTER_DRAIN = false;
    const float* ss2; bf16_t* hid;
    __device__ __forceinline__ void operator()(const f32x4 (&acc)[2][2][4][2], const Unit& u, int wr, int wc, int fr, int fq) const {
#pragma unroll
        for (int ai = 0; ai < 2; ++ai)
#pragma unroll
            for (int m = 0; m < 4; ++m) {
                const int row = u.pm * 256 + ai * 128 + wr * 64 + m * 16 + fr;
                const float r = __builtin_amdgcn_rsqf(ss2[row] * (1.f / 1024.f) + 1e-6f);
                float h[8];
#pragma unroll
                for (int n = 0; n < 2; ++n)
#pragma unroll
                    for (int i = 0; i < 4; ++i) { const float g = acc[ai][0][m][n][i] * r, uu = acc[ai][1][m][n][i] * r;
                        h[n * 4 + i] = g * __builtin_amdgcn_rcpf(1.f + __builtin_amdgcn_exp2f(-1.4426950408889634f * g)) * uu; }
                u32x4 w; w.x = cvt_pk_bf16(h[0], h[1]); w.y = cvt_pk_bf16(h[2], h[3]); w.z = cvt_pk_bf16(h[4], h[5]); w.w = cvt_pk_bf16(h[6], h[7]);
                *(u32x4*)(hid + (size_t)row * 2816 + u.pn * 128 + wc * 32 + 8 * fq) = w;
            }
    }
};

struct EpiRes2 {
    static constexpr bool PERM = true, AFTER_DRAIN = false;
    float* out;
    __device__ __forceinline__ void operator()(const f32x4 (&acc)[2][2][4][2], const Unit& u, int wr, int wc, int fr, int fq) const {
#pragma unroll
        for (int ai = 0; ai < 2; ++ai)
#pragma unroll
            for (int m = 0; m < 4; ++m) {
                const int row = u.pm * 256 + ai * 128 + wr * 64 + m * 16 + fr;
#pragma unroll
                for (int bj = 0; bj < 2; ++bj) {
                    float* p = out + (size_t)row * 1024 + u.pn * 256 + bj * 128 + wc * 32 + 8 * fq;
                    *(f32x4*)(p) = *(const f32x4*)(p) + acc[ai][bj][m][0]; *(f32x4*)(p + 4) = *(const f32x4*)(p + 4) + acc[ai][bj][m][1];
                }
            }
    }
};
template <class Epi, class Sched, bool ALIGN_EPI = false, bool SP2 = false>
__device__ __forceinline__ void gemm_phase(PG8_LAS unsigned char* lds, const Gemm g, const Sched& S, const Epi& E) {
    const int tid = threadIdx.x, wid = __builtin_amdgcn_readfirstlane(tid >> 6), lane = tid & 63, wr = wid >> 2, wc = wid & 3, fr = lane & 15, fq = lane >> 4;
    const int K = g.K, nt = K / BK;
    unsigned voffA[2], voffB[2];
#pragma unroll
    for (int i = 0; i < 2; ++i) { int R, C; stage_rc(tid * 16 + i * 8192, R, C); const int Rb = Epi::PERM ? ((R & ~31) + perm32(R & 31)) : R;
        voffA[i] = (unsigned)(R * K + C) * 2u; voffB[i] = (unsigned)(Rb * K + C) * 2u; }
    const size_t kstep = (size_t)(BK * 2);
    const size_t hstep = (size_t)HALF * K * 2;
    const size_t tstep = 2 * hstep;
    const unsigned ldsw = (unsigned)wid * 1024u;
    const int aoff = lds_byte(wr * 64 + fr, fq * 8), boff = lds_byte(wc * 32 + fr, fq * 8);
#define PG8_SA(b, h) (((b) * 2 + (h)) * HTB)
#define PG8_SB(b, h) ((4 + (b) * 2 + (h)) * HTB)
#define PG8_STAGE(bufoff, gbase, voff) do { _Pragma("unroll") for (int _i = 0; _i < 2; ++_i) \
        __builtin_amdgcn_global_load_lds((const unsigned*)((const char*)(gbase) + (voff)[_i]), (PG8_LAS unsigned*)(lds + (bufoff) + ldsw + _i * 8192), 16, 0, 0); } while (0)
#define PG8_LDA(dst, b, h) do { _Pragma("unroll") for (int m = 0; m < 4; ++m) _Pragma("unroll") for (int k = 0; k < 2; ++k) dst[m][k] = *(const PG8_LAS bf16x8*)(lds + PG8_SA(b, h) + aoff + m * 2048 + k * 1024); } while (0)
#define PG8_LDB(dst, b, h) do { _Pragma("unroll") for (int n = 0; n < 2; ++n) _Pragma("unroll") for (int k = 0; k < 2; ++k) dst[n][k] = *(const PG8_LAS bf16x8*)(lds + PG8_SB(b, h) + boff + n * 2048 + k * 1024); } while (0)
#define PG8_MMA(ai, bj, At, Bt) do { __builtin_amdgcn_s_setprio(1); _Pragma("unroll") for (int m = 0; m < 4; ++m) _Pragma("unroll") for (int n = 0; n < 2; ++n) _Pragma("unroll") for (int k = 0; k < 2; ++k) \
        acc[ai][bj][m][n] = __builtin_amdgcn_mfma_f32_16x16x32_bf16(Bt[n][k], At[m][k], acc[ai][bj][m][n], 0, 0, 0); __builtin_amdgcn_s_setprio(0); } while (0)
#define PG8_WAIT_V(n) asm volatile("s_waitcnt vmcnt(" #n ")" ::: "memory")
#define PG8_WAIT_L(n) asm volatile("s_waitcnt lgkmcnt(" #n ")" ::: "memory")
#define PG8_BAR __builtin_amdgcn_s_barrier()
#define PG8_SCHED __builtin_amdgcn_sched_barrier(0)
    Unit cur, nxt; int ui = 0;
    if (!S.next(0, cur)) return;
    f32x4 acc[2][2][4][2];
#pragma unroll
    for (int a = 0; a < 2; ++a)
#pragma unroll
        for (int b = 0; b < 2; ++b)
#pragma unroll
            for (int m = 0; m < 4; ++m)
#pragma unroll
                for (int n = 0; n < 2; ++n) acc[a][b][m][n] = (f32x4){0.f, 0.f, 0.f, 0.f};
    bf16x8 At[4][2], B0[2][2], B1[2][2];
    const char* cA = (const char*)g.A + (size_t)cur.pm * tstep; const char* cB = (const char*)g.Bt + (size_t)cur.pn * tstep;
    S.a_ready(cur);
    if constexpr (SP2) {
        PG8_STAGE(PG8_SB(0, 0), cB, voffB); PG8_STAGE(PG8_SB(0, 1), cB + hstep, voffB); PG8_STAGE(PG8_SA(0, 0), cA, voffA); PG8_STAGE(PG8_SA(0, 1), cA + hstep, voffA);
        if (wr == 1) PG8_BAR;
        PG8_WAIT_V(2); PG8_BAR;
        PG8_STAGE(PG8_SB(1, 0), cB + kstep, voffB); PG8_STAGE(PG8_SA(1, 0), cA + kstep, voffA); PG8_STAGE(PG8_SB(1, 1), cB + hstep + kstep, voffB);
        PG8_WAIT_V(6); PG8_BAR;
    } else {
        PG8_STAGE(PG8_SB(0, 0), cB, voffB); PG8_STAGE(PG8_SA(0, 0), cA, voffA); PG8_STAGE(PG8_SB(0, 1), cB + hstep, voffB); PG8_STAGE(PG8_SA(0, 1), cA + hstep, voffA);
        if (wr == 1) PG8_BAR;
        PG8_WAIT_V(4); PG8_BAR;
        PG8_STAGE(PG8_SB(1, 0), cB + kstep, voffB); PG8_STAGE(PG8_SA(1, 0), cA + kstep, voffA); PG8_STAGE(PG8_SB(1, 1), cB + hstep + kstep, voffB);
        PG8_WAIT_V(6); PG8_BAR;
    }
    for (;;) {
        const bool has_next = S.next(ui + 1, nxt);
        const char* nA = has_next ? (const char*)g.A + (size_t)nxt.pm * tstep : cA; const char* nB = has_next ? (const char*)g.Bt + (size_t)nxt.pn * tstep : cB;
        for (int t = 0; t < nt; t += 2) {
            const bool last = (t == nt - 2);
            const char* a1 = cA + (size_t)(t + 1) * kstep;
            const char* a2 = last ? nA : cA + (size_t)(t + 2) * kstep; const char* b2 = last ? nB : cB + (size_t)(t + 2) * kstep;
            const char* a3 = a2 + kstep; const char* b3 = b2 + kstep;
            if (last && has_next) S.a_ready(nxt);
            if constexpr (SP2) {
            PG8_LDB(B0, 0, 0); PG8_LDB(B1, 0, 1); PG8_SCHED; PG8_LDA(At, 0, 0); PG8_STAGE(PG8_SA(1, 1), a1 + hstep, voffA);
            PG8_WAIT_V(8); PG8_WAIT_L(0); PG8_BAR; PG8_MMA(0, 0, At, B0); PG8_MMA(0, 1, At, B1); PG8_BAR; PG8_SCHED;
            PG8_LDA(At, 0, 1); PG8_STAGE(PG8_SB(0, 0), b2, voffB); PG8_STAGE(PG8_SB(0, 1), b2 + hstep, voffB); PG8_STAGE(PG8_SA(0, 0), a2, voffA);
            PG8_WAIT_V(8); PG8_WAIT_L(0); PG8_BAR; PG8_MMA(1, 0, At, B0); PG8_MMA(1, 1, At, B1); PG8_BAR; PG8_SCHED;
            PG8_LDB(B0, 1, 0); PG8_LDB(B1, 1, 1); PG8_SCHED; PG8_LDA(At, 1, 0); PG8_STAGE(PG8_SA(0, 1), a2 + hstep, voffA);
            PG8_WAIT_V(8); PG8_WAIT_L(0); PG8_BAR; PG8_MMA(0, 0, At, B0); PG8_MMA(0, 1, At, B1); PG8_BAR; PG8_SCHED;
            PG8_LDA(At, 1, 1); PG8_STAGE(PG8_SB(1, 0), b3, voffB); PG8_STAGE(PG8_SB(1, 1), b3 + hstep, voffB); PG8_STAGE(PG8_SA(1, 0), a3, voffA);
            PG8_WAIT_V(8); PG8_WAIT_L(0); PG8_BAR; PG8_MMA(1, 0, At, B0); PG8_MMA(1, 1, At, B1); PG8_BAR; PG8_SCHED;
            } else {
            PG8_LDB(B0, 0, 0); PG8_SCHED; PG8_LDA(At, 0, 0); PG8_STAGE(PG8_SA(1, 1), a1 + hstep, voffA);
            PG8_WAIT_L(8); PG8_BAR; PG8_WAIT_L(0); PG8_MMA(0, 0, At, B0); PG8_BAR; PG8_SCHED;
            PG8_LDB(B1, 0, 1); PG8_STAGE(PG8_SB(0, 0), b2, voffB);
            PG8_BAR; PG8_WAIT_L(0); PG8_MMA(0, 1, At, B1); PG8_BAR;
            PG8_LDA(At, 0, 1); PG8_STAGE(PG8_SA(0, 0), a2, voffA);
            PG8_BAR; PG8_WAIT_L(0); PG8_MMA(1, 0, At, B0); PG8_BAR; PG8_SCHED;
            PG8_STAGE(PG8_SB(0, 1), b2 + hstep, voffB);
            PG8_WAIT_V(6); PG8_BAR; PG8_MMA(1, 1, At, B1); PG8_BAR;
            PG8_LDB(B0, 1, 0); PG8_SCHED; PG8_LDA(At, 1, 0); PG8_STAGE(PG8_SA(0, 1), a2 + hstep, voffA);
            PG8_WAIT_L(8); PG8_BAR; PG8_WAIT_L(0); PG8_MMA(0, 0, At, B0); PG8_BAR; PG8_SCHED;
            PG8_LDB(B1, 1, 1); PG8_STAGE(PG8_SB(1, 0), b3, voffB);
            PG8_BAR; PG8_WAIT_L(0); PG8_MMA(0, 1, At, B1); PG8_BAR;
            PG8_LDA(At, 1, 1); PG8_STAGE(PG8_SA(1, 0), a3, voffA);
            PG8_BAR; PG8_WAIT_L(0); PG8_MMA(1, 0, At, B0); PG8_BAR; PG8_SCHED;
            PG8_STAGE(PG8_SB(1, 1), b3 + hstep, voffB);
            PG8_WAIT_V(6); PG8_BAR; PG8_MMA(1, 1, At, B1); PG8_BAR;
            }
        }
        if constexpr (ALIGN_EPI) { if (wr == 0) PG8_BAR; }
        if constexpr (!Epi::AFTER_DRAIN) { E(acc, cur, wr, wc, fr, fq); S.done(cur); }
        if (!has_next) break;
#pragma unroll
        for (int a = 0; a < 2; ++a)
#pragma unroll
            for (int b = 0; b < 2; ++b)
#pragma unroll
                for (int m = 0; m < 4; ++m)
#pragma unroll
                    for (int n = 0; n < 2; ++n) acc[a][b][m][n] = (f32x4){0.f, 0.f, 0.f, 0.f};
        cur = nxt; cA = nA; cB = nB; ++ui;
        if constexpr (ALIGN_EPI) { if (wr == 1) PG8_BAR; }
    }
    PG8_WAIT_V(0);
    if constexpr (!ALIGN_EPI) { if (wr == 0) PG8_BAR; }
    PG8_BAR;
    if constexpr (Epi::AFTER_DRAIN) { E.fused(acc, cur, wr, wc, fr, fq, lds, wid, lane); S.done(cur); }
#undef PG8_SA
#undef PG8_SB
#undef PG8_STAGE
#undef PG8_LDA
#undef PG8_LDB
#undef PG8_MMA
#undef PG8_WAIT_V
#undef PG8_WAIT_L
#undef PG8_BAR
#undef PG8_SCHED
}
}
namespace att {
using bf16x8 = __attribute__((ext_vector_type(8))) short;
using s16x4 = __attribute__((ext_vector_type(4))) short;
using f32x16 = __attribute__((ext_vector_type(16))) float;
using u32x4 = __attribute__((ext_vector_type(4))) unsigned;
typedef short v4i16_t __attribute__((ext_vector_type(4)));
typedef __attribute__((address_space(3))) const char* lds_cptr;
typedef __attribute__((address_space(3))) char* lds_ptr;
constexpr int L_K = 0, L_V = 16384, L_WS = 49152, L_OST = 51200, L_END = L_OST + 8 * 8192;
__device__ __forceinline__ int crow(int r, int hi) { return (r & 3) + 8 * (r >> 2) + 4 * hi; }
__device__ __forceinline__ unsigned cvtpk(float lo, float hi) { unsigned r; asm volatile("v_cvt_pk_bf16_f32 %0, %1, %2" : "=v"(r) : "v"(lo), "v"(hi)); return r; }
__device__ __forceinline__ s16x4 vtr(lds_cptr p) { return __builtin_bit_cast(s16x4, __builtin_amdgcn_ds_read_tr16_b64_v4i16((__attribute__((address_space(3))) v4i16_t*)p)); }
__device__ __forceinline__ float wave_max(float v) { for (int o = 1; o < 64; o <<= 1) v = fmaxf(v, __shfl_xor(v, o)); return v; }
__device__ __forceinline__ float wave_sum(float v) { for (int o = 1; o < 64; o <<= 1) v += __shfl_xor(v, o); return v; }

template <int NDB>
__device__ __forceinline__ void sweep(const bf16_t* Qp, const bf16_t* Kt, const bf16_t* Vt, float negMc, lds_ptr shm, f32x16 (&o)[NDB], float& l_out) {
    const int tid = threadIdx.x, lane = tid & 63, r32 = lane & 31, hi = lane >> 5; const int wid = __builtin_amdgcn_readfirstlane(tid >> 6);
    bf16x8 qr[4];
#pragma unroll
    for (int d0 = 0; d0 < 4; ++d0) qr[d0] = *(const bf16x8*)(Qp + (size_t)(wid * 32 + r32) * 64 + d0 * 16 + hi * 8);
#pragma unroll
    for (int db = 0; db < NDB; ++db)
#pragma unroll
        for (int r = 0; r < 16; ++r) o[db][r] = 0.f;
    float l = 0.f;
    const u32x4* kg = (const u32x4*)Kt + tid; const u32x4* vg = (const u32x4*)Vt + tid;
    u32x4 kreg = kg[0]; u32x4 vreg[NDB / 2];
#pragma unroll
    for (int i = 0; i < NDB / 2; ++i) vreg[i] = vg[i * 512];
    *(__attribute__((address_space(3))) u32x4*)(shm + L_K + tid * 16) = kreg;
#pragma unroll
    for (int i = 0; i < NDB / 2; ++i) *(__attribute__((address_space(3))) u32x4*)(shm + L_V + i * 8192 + tid * 16) = vreg[i];
    __syncthreads();
    const lds_cptr kp0 = (lds_cptr)shm + L_K + hi * 1024 + r32 * 16;
    const lds_cptr vp0 = (lds_cptr)shm + L_V + ((lane >> 4) & 1) * 32 + (lane & 3) * 8 + (4 * hi + ((lane & 15) >> 2)) * 64;
    for (int t = 0; t < 65; ++t) {
        const int cur = t & 1;
        if (t + 1 < 65) { kreg = kg[(size_t)(t + 1) * 512];
#pragma unroll
            for (int i = 0; i < NDB / 2; ++i) vreg[i] = vg[(size_t)(t + 1) * (NDB * 256) + i * 512]; }
        const lds_cptr kp = kp0 + cur * 8192; const lds_cptr vp = vp0 + cur * 16384;
        float nm = negMc; asm volatile("" : "+v"(nm));
        const float big = (t == 0) ? -30000.f : nm;
        f32x16 c0, c1;
#pragma unroll
        for (int r = 0; r < 16; ++r) { c0[r] = (r < 8) ? nm : big; c1[r] = big; }
#pragma unroll
        for (int d0 = 0; d0 < 4; ++d0) {
            const bf16x8 b0 = *(const __attribute__((address_space(3))) bf16x8*)(kp + d0 * 2048);
            const bf16x8 b1 = *(const __attribute__((address_space(3))) bf16x8*)(kp + d0 * 2048 + 512);
            c0 = __builtin_amdgcn_mfma_f32_32x32x16_bf16(b0, qr[d0], c0, 0, 0, 0);
            c1 = __builtin_amdgcn_mfma_f32_32x32x16_bf16(b1, qr[d0], c1, 0, 0, 0);
        }
        __builtin_amdgcn_sched_barrier(0);
        float sacc = 0.f;
#pragma unroll
        for (int r = 0; r < 16; ++r) { c0[r] = __builtin_amdgcn_exp2f(c0[r]); c1[r] = __builtin_amdgcn_exp2f(c1[r]); sacc += c0[r] + c1[r]; }
        l += sacc;
        u32x4 pw[4];
#pragma unroll
        for (int k = 0; k < 2; ++k) {
            pw[k] = (u32x4){cvtpk(c0[8 * k + 0], c0[8 * k + 1]), cvtpk(c0[8 * k + 2], c0[8 * k + 3]), cvtpk(c0[8 * k + 4], c0[8 * k + 5]), cvtpk(c0[8 * k + 6], c0[8 * k + 7])};
            pw[2 + k] = (u32x4){cvtpk(c1[8 * k + 0], c1[8 * k + 1]), cvtpk(c1[8 * k + 2], c1[8 * k + 3]), cvtpk(c1[8 * k + 4], c1[8 * k + 5]), cvtpk(c1[8 * k + 6], c1[8 * k + 7])};
        }
#pragma unroll
        for (int db = 0; db < NDB; ++db) {
            __builtin_amdgcn_sched_barrier(0);
#pragma unroll
            for (int ks = 0; ks < 4; ++ks) {
                const s16x4 lo = vtr(vp + db * 4096 + ks * 1024), hi4 = vtr(vp + db * 4096 + ks * 1024 + 512);
                const bf16x8 vf = (bf16x8){lo[0], lo[1], lo[2], lo[3], hi4[0], hi4[1], hi4[2], hi4[3]};
                o[db] = __builtin_amdgcn_mfma_f32_32x32x16_bf16(__builtin_bit_cast(bf16x8, pw[ks]), vf, o[db], 0, 0, 0);
            }
        }
        __builtin_amdgcn_sched_barrier(0);
        if (t + 1 < 65) {
            *(__attribute__((address_space(3))) u32x4*)(shm + L_K + (cur ^ 1) * 8192 + tid * 16) = kreg;
#pragma unroll
            for (int i = 0; i < NDB / 2; ++i) *(__attribute__((address_space(3))) u32x4*)(shm + L_V + (cur ^ 1) * 16384 + i * 8192 + tid * 16) = vreg[i];
        }
        __syncthreads();
    }
    l += __shfl_xor(l, 32);
    l_out = l;
}

__device__ __forceinline__ void inv_l_regs(float l, lds_ptr shm, int wid, int r32_, int hi_, float (&rli)[16]) {
    int r32 = r32_, hi = hi_; asm volatile("" : "+v"(r32), "+v"(hi));
    __attribute__((address_space(3))) float* wsf = (__attribute__((address_space(3))) float*)(shm + L_WS) + wid * 64;
    if (hi == 0) wsf[r32] = l;
    asm volatile("s_waitcnt lgkmcnt(0)" ::: "memory");
    const __attribute__((address_space(3))) float* rp = wsf + 4 * hi;
#pragma unroll
    for (int r = 0; r < 16; ++r) rli[r] = __builtin_amdgcn_rcpf(rp[(r & 3) + 8 * (r >> 2)]);
    asm volatile("s_waitcnt lgkmcnt(0)" ::: "memory");
}
template <int NDB>
__device__ __forceinline__ void store_rows(const f32x16 (&v)[NDB], lds_ptr shm, int wid, int lane_, bf16_t* dst) {
    int lane = lane_; asm volatile("" : "+v"(lane));
    const int r32 = lane & 31, hi = lane >> 5;
    __attribute__((address_space(3))) bf16_t* stg = (__attribute__((address_space(3))) bf16_t*)(shm + L_OST + wid * 8192);
    __attribute__((address_space(3))) bf16_t* wp = stg + (4 * hi) * (NDB * 32) + r32;
#pragma unroll
    for (int r = 0; r < 16; ++r)
#pragma unroll
        for (int db = 0; db < NDB; ++db) wp[((r & 3) + 8 * (r >> 2)) * (NDB * 32) + db * 32] = (bf16_t)f2bf(v[db][r]);
    asm volatile("s_waitcnt lgkmcnt(0)" ::: "memory");
    constexpr int CPR = NDB * 4;
    const int row0 = lane / CPR, ch = lane % CPR;
    const __attribute__((address_space(3))) bf16_t* rp = stg + row0 * (NDB * 32) + ch * 8; bf16_t* gp = dst + (size_t)row0 * 1024 + ch * 8;
#pragma unroll
    for (int i = 0; i < (32 * CPR) / 64; ++i) {
        const u32x4 w = *(const __attribute__((address_space(3))) u32x4*)(rp + i * (64 / CPR) * (NDB * 32));
        *(u32x4*)(gp + (size_t)i * (64 / CPR) * 1024) = w; }
    asm volatile("s_waitcnt lgkmcnt(0)" ::: "memory");
}

struct Tensors { const bf16_t *QA, *QB, *KA, *VA, *KB, *VB; bf16_t* MIX; float* stash; const float *gqa, *gka, *gqb, *gkb, *lq1, *lk1, *lq2, *lk2, *subg; };

__device__ __forceinline__ void phase(lds_ptr shm, const Tensors& T, int vcu, int G) {
    const int tid = threadIdx.x, lane = tid & 63, r32 = lane & 31, hi = lane >> 5; const int wid = __builtin_amdgcn_readfirstlane(tid >> 6);
    const float McA = 8.f * wave_max(fabsf(T.gqa[lane])) * wave_max(fabsf(T.gka[lane])) * 1.4426950408889634f;
    const float McB = 8.f * wave_max(fabsf(T.gqb[lane])) * wave_max(fabsf(T.gkb[lane])) * 1.4426950408889634f;
    const float lam = __expf(wave_sum(T.lq1[lane] * T.lk1[lane])) - __expf(wave_sum(T.lq2[lane] * T.lk2[lane])) + 0.2f;
    for (int item = vcu; item < 1536; item += G) {
        if (item < 1024) {
            const int b = (item >> 5) & 7, j = item & 31, i = item >> 8, kvh = i >> 1, idx = (i & 1) * 32 + j, h = kvh * 4 + (idx >> 4), qb = idx & 15;
            f32x16 o[2]; float l;
            sweep<2>(T.QA + ((size_t)(b * 8 + h) * 4096 + qb * 256) * 64, T.KA + (size_t)(b * 2 + kvh) * 65 * 4096, T.VA + (size_t)(b * 2 + kvh) * 65 * 4096, -McA, shm, o, l);
            float rli[16]; inv_l_regs(l, shm, wid, r32, hi, rli);
#pragma unroll
            for (int db = 0; db < 2; ++db)
#pragma unroll
                for (int r = 0; r < 16; ++r) o[db][r] *= rli[r];
            store_rows<2>(o, shm, wid, lane, T.MIX + (size_t)(b * 4096 + qb * 256 + wid * 32) * 1024 + h * 64);
        } else {
            const int wb = item - 1024, b = (wb >> 5) & 7, j = wb & 31, i = wb >> 8, idx = i * 32 + j, hb = idx >> 4, qb = idx & 15;
            float* st = T.stash + ((size_t)(blockIdx.x * 8 + wid) * 64) * 64 + lane;
            asm volatile("" : "+v"(st));
            f32x16 o[4]; float l; float rli[16];
            sweep<4>(T.QB + ((size_t)(b * 8 + 2 * hb) * 4096 + qb * 256) * 64, T.KB + (size_t)(b * 8 + 2 * hb) * 65 * 4096, T.VB + (size_t)(b * 4 + hb) * 65 * 8192, -McB, shm, o, l);
            inv_l_regs(l, shm, wid, r32, hi, rli);
#pragma unroll
            for (int db = 0; db < 4; ++db)
#pragma unroll
                for (int r = 0; r < 16; ++r) st[(db * 16 + r) * 64] = o[db][r] * rli[r];
            sweep<4>(T.QB + ((size_t)(b * 8 + 2 * hb + 1) * 4096 + qb * 256) * 64, T.KB + (size_t)(b * 8 + 2 * hb + 1) * 65 * 4096, T.VB + (size_t)(b * 4 + hb) * 65 * 8192, -McB, shm, o, l);
            inv_l_regs(l, shm, wid, r32, hi, rli);
            asm volatile("" : "+v"(st));
            float ssq[16];
#pragma unroll
            for (int r = 0; r < 16; ++r) ssq[r] = 0.f;
#pragma unroll
            for (int db = 0; db < 4; ++db)
#pragma unroll
                for (int r = 0; r < 16; ++r) { const float v = st[(db * 16 + r) * 64] - lam * (o[db][r] * rli[r]); o[db][r] = v; ssq[r] += v * v; }
#pragma unroll
            for (int r = 0; r < 16; ++r) { float s = ssq[r]; s += __shfl_xor(s, 1); s += __shfl_xor(s, 2); s += __shfl_xor(s, 4); s += __shfl_xor(s, 8); s += __shfl_xor(s, 16);
                ssq[r] = __builtin_amdgcn_rsqf(s * (1.f / 128.f) + 1e-6f) * 0.8f; }
#pragma unroll
            for (int db = 0; db < 4; ++db) { const float g = T.subg[db * 32 + r32];
#pragma unroll
                for (int r = 0; r < 16; ++r) o[db][r] *= ssq[r] * g; }
            store_rows<4>(o, shm, wid, lane, T.MIX + (size_t)(b * 4096 + qb * 256 + wid * 32) * 1024 + 512 + hb * 128);
        }
    }
}
}
#define GAS __attribute__((address_space(1)))
#define LAS __attribute__((address_space(3)))
typedef unsigned v4u __attribute__((ext_vector_type(4)));
typedef float f32x4 __attribute__((ext_vector_type(4)));
typedef GAS unsigned gu32;
typedef GAS unsigned long long gu64;
#define RLX_AGENT __ATOMIC_RELAXED, __HIP_MEMORY_SCOPE_AGENT
#define LDS_WAIT() asm volatile("s_waitcnt lgkmcnt(0)" ::: "memory")
#define VM_WAIT() asm volatile("s_waitcnt vmcnt(0)" ::: "memory")
__device__ __forceinline__ unsigned pk2(float lo, float hi) { return f2bf(lo) | (f2bf(hi) << 16); }
#define XB_TMO      128
#define XB_XCNT(j)  (256  + 64 * (j))
#define XB_XSUB(j)  (1280 + 64 * (j))
#define XB_XGEN(j)  (2304 + 64 * (j))
#define XB_TOP      3328
#define XB_TOPGEN   3392
#define XCD_BAR_WORDS 3456
#define XB_SPIN_CAP (1u << 18)

__device__ __forceinline__ unsigned xb_ld(unsigned* p)              { return __hip_atomic_load(p, __ATOMIC_RELAXED, __HIP_MEMORY_SCOPE_AGENT); }
__device__ __forceinline__ unsigned xb_add(unsigned* p, unsigned v) { return __hip_atomic_fetch_add(p, v, __ATOMIC_RELAXED, __HIP_MEMORY_SCOPE_AGENT); }
__device__ __forceinline__ unsigned xb_xcc_id() { return (unsigned)__builtin_amdgcn_s_getreg((3 << 11) | 20) & 0xFu; }
#define XB_SPIN(cond, bar) do { unsigned _sp = 0; while (cond) { __builtin_amdgcn_s_sleep(1); \
    if ((++_sp & 255u) == 0u) { if (xb_ld(&(bar)[XB_TMO])) break; if (_sp > XB_SPIN_CAP) { atomicAdd(&(bar)[XB_TMO], 1u); break; } } } } while (0)

struct XcdBarrier {
    unsigned* bar; unsigned x;
    volatile LAS unsigned* st;
};

__device__ __forceinline__ XcdBarrier xcd_barrier_post(unsigned* bar, volatile LAS unsigned* st) {
    XcdBarrier b; b.bar = bar; b.x = xb_xcc_id(); b.st = st;
    if (threadIdx.x == 0) (void)xb_add(&bar[XB_XCNT(b.x)], 1u);
    return b;
}
__device__ __forceinline__ void xcd_barrier_complete(unsigned* bar, unsigned x, unsigned& nloc, unsigned& nx) {
    const unsigned G = gridDim.x * gridDim.y * gridDim.z;
    unsigned sum, cnt, mine, sp = 0u;
    for (;;) {
        sum = 0u; cnt = 0u; mine = 0u;
#pragma unroll
        for (unsigned j = 0; j < 16; ++j) { const unsigned c = xb_ld(&bar[XB_XCNT(j)]); sum += c; cnt += (c > 0u) ? 1u : 0u; mine = (j == x) ? c : mine; }
        if (sum == G) break;
        __builtin_amdgcn_s_sleep(1);
        if ((++sp & 255u) == 0u) { if (xb_ld(&bar[XB_TMO])) break; if (sp > XB_SPIN_CAP) { atomicAdd(&bar[XB_TMO], 1u); break; } }
    }
    nloc = mine > 0u ? mine : 1u; nx = cnt > 0u ? cnt : 1u;
}

__device__ __forceinline__ void xcd_barrier(const XcdBarrier& b) {
    asm volatile("s_waitcnt vmcnt(0)" ::: "memory");
    __syncthreads();
    if (threadIdx.x == 0) {
        unsigned* bar = b.bar;
        __builtin_amdgcn_s_waitcnt(0);
        unsigned nloc = b.st[0], nx = b.st[1];
        if (nloc == 0u) { xcd_barrier_complete(bar, b.x, nloc, nx); b.st[0] = nloc; b.st[1] = nx; }
        const unsigned old = xb_add(&bar[XB_XSUB(b.x)], 1u);
        const unsigned gen = old / nloc;
        if (old + 1u == (gen + 1u) * nloc) {
            __builtin_amdgcn_fence(__ATOMIC_RELEASE, "agent");
            asm volatile("s_waitcnt vmcnt(0)" ::: "memory");
            const unsigned og = xb_add(&bar[XB_TOP], 1u);
            const unsigned tg = og / nx;
            if (og + 1u == (tg + 1u) * nx) xb_add(&bar[XB_TOPGEN], 1u);
            else XB_SPIN(xb_ld(&bar[XB_TOPGEN]) == tg, bar);
            __builtin_amdgcn_fence(__ATOMIC_ACQUIRE, "agent");
            xb_add(&bar[XB_XGEN(b.x)], 1u);
            asm volatile("s_waitcnt vmcnt(0)" ::: "memory");
        } else {
            XB_SPIN(xb_ld(&bar[XB_XGEN(b.x)]) == gen, bar);
            __builtin_amdgcn_fence(__ATOMIC_ACQUIRE, "agent");
            asm volatile("s_waitcnt vmcnt(0)" ::: "memory");
        }
    }
    __syncthreads();
}
constexpr int NWAVES = 8;
constexpr int RING_OFF = 0, RING_BYTES = 131072, LDSCTL_OFF = RING_BYTES, MISC_OFF = LDSCTL_OFF + 320, LDS_BYTES = 147456;
static_assert(att::L_END <= RING_BYTES, "attention LDS map");
constexpr int CW_BAR = 4096;
constexpr size_t CTL_ZERO_BYTES = 64 * 1024;
static_assert(WS_TA + 4097ull * 256 <= WS_TB && WS_TB + 4112ull * 256 <= WS_BT1 && WS_BT1 + 2304ull * 2048 <= WS_BT3 && WS_BT3 + 1024ull * 2048 <= WS_BT4 && WS_BT4 + 5632ull * 2048 <= WS_BT5 && WS_BT5 + 1024ull * 5632 <= WS_XB, "ws map 2");
static_assert(WS_STASH + 256ull * 8 * 64 * 64 * 4 <= WS_END, "stash");

struct Args { const float* in[18]; float* out; unsigned char* ws; RopeInv inv; int ph_lo, ph_hi; };
static_assert(sizeof(Args) == 18 * 8 + 8 + 8 + 192 + 8, "Args has no padding");

__device__ __forceinline__ float wave_sum_f(float v) {
#pragma unroll
    for (int o = 1; o < 64; o <<= 1) v += __shfl_xor(v, o);
    return v;
}
__device__ __forceinline__ void p0_transpose_item(const float* W, int K, int N, bf16_t* WT, int drow0, const float* gain, LAS float* scr, int kb, int n0, int lane) {
    const int k0 = 64 * kb;
#pragma unroll 8
    for (int i = 0; i < 32; ++i) { const int kk = 2 * i + (lane >> 5); scr[kk * 33 + (lane & 31)] = W[(size_t)(k0 + kk) * N + n0 + (lane & 31)] * (gain ? gain[k0 + kk] : 1.f); }
    LDS_WAIT(); asm volatile("" ::: "memory");
    const int c = lane & 7;
#pragma unroll
    for (int j = 0; j < 4; ++j) { const int n = (lane >> 3) + 8 * j; const LAS float* s = scr + (8 * c) * 33 + n;
        v4u o; o.x = pk2(s[0 * 33], s[1 * 33]); o.y = pk2(s[2 * 33], s[3 * 33]); o.z = pk2(s[4 * 33], s[5 * 33]); o.w = pk2(s[6 * 33], s[7 * 33]);
        *(GAS v4u*)(WT + (size_t)(drow0 + n) * K + k0 + 8 * c) = o; }
    LDS_WAIT(); asm volatile("" ::: "memory");
}

__device__ __forceinline__ void p0_prologue(const Args& A, LAS unsigned char* lds, int vcu, int G, int wave, int lane) {
    const float* x = A.in[0]; const float* meta = A.in[1]; const float* g1 = A.in[2]; const float* w_in = A.in[3]; const float* w_out = A.in[13]; const float* g2 = A.in[14];
    const float* w_gate = A.in[15]; const float* w_up = A.in[16]; const float* w_down = A.in[17];
    unsigned char* ws = A.ws;
    bf16_t *Bt1 = (bf16_t*)(ws + WS_BT1), *Bt3 = (bf16_t*)(ws + WS_BT3), *Bt4 = (bf16_t*)(ws + WS_BT4), *Bt5 = (bf16_t*)(ws + WS_BT5), *XB = (bf16_t*)(ws + WS_XB);
    float *ss = (float*)(ws + WS_RS), *ss2 = (float*)(ws + WS_SS), *TA = (float*)(ws + WS_TA), *TB = (float*)(ws + WS_TB);
    LAS float* scr = (LAS float*)(lds + RING_OFF + wave * 16384);
    const int gw = vcu * NWAVES + wave, NGW = G * NWAVES;
    constexpr int I_IN = 16 * 72, I_OUT = 16 * 32, I_G = 16 * 88, I_D = 44 * 32, NITEMS = I_IN + I_OUT + 2 * I_G + I_D;
    for (int it = gw; it < NITEMS; it += NGW) {
        int r = it;
        if (r < I_IN) { const int kb = r / 72, nb = r % 72, c0 = nb * 32; p0_transpose_item(w_in, 1024, 2304, Bt1, (c0 & ~255) + 128 * ((c0 & 63) >> 5) + 32 * ((c0 & 255) >> 6), g1, scr, kb, c0, lane); continue; } r -= I_IN;
        if (r < I_OUT) { const int kb = r / 32, nb = r % 32; p0_transpose_item(w_out, 1024, 1024, Bt3, nb * 32, nullptr, scr, kb, nb * 32, lane); continue; } r -= I_OUT;
        if (r < I_G) { const int kb = r / 88, nb = r % 88, f0 = nb * 32; p0_transpose_item(w_gate, 1024, 2816, Bt4, 256 * (f0 >> 7) + (f0 & 127), g2, scr, kb, f0, lane); continue; } r -= I_G;
        if (r < I_G) { const int kb = r / 88, nb = r % 88, f0 = nb * 32; p0_transpose_item(w_up, 1024, 2816, Bt4, 256 * (f0 >> 7) + 128 + (f0 & 127), g2, scr, kb, f0, lane); continue; } r -= I_G;
        { const int kb = r / 32, nb = r % 32; p0_transpose_item(w_down, 2816, 1024, Bt5, nb * 32, nullptr, scr, kb, nb * 32, lane); }
    }
    for (int m = gw; m < 33024; m += NGW) {
        GAS unsigned long long* o8 = (GAS unsigned long long*)(XB + (size_t)m * 1024) + lane;
        if (m < NTOK + NMETA) {
            const GAS f32x4* xr = (const GAS f32x4*)(m < NTOK ? x + (size_t)m * 1024 : meta + (size_t)(m - NTOK) * 1024) + lane;
            f32x4 v[4]; float s = 0.f;
#pragma unroll
            for (int j = 0; j < 4; ++j) { v[j] = xr[64 * j]; s += (v[j].x * v[j].x + v[j].y * v[j].y) + (v[j].z * v[j].z + v[j].w * v[j].w); }
            s = wave_sum_f(s);
#pragma unroll
            for (int j = 0; j < 4; ++j) o8[64 * j] = (unsigned long long)pk2(v[j].x, v[j].y) | ((unsigned long long)pk2(v[j].z, v[j].w) << 32);
            if (lane == 0) ss[m] = s;
        } else {
#pragma unroll
            for (int j = 0; j < 4; ++j) o8[64 * j] = 0ull;
            if (lane == 0) ss[m] = 1024.f;
        }
    }
    const int gt = gw * 64 + lane, NGT = NGW * 64;
    for (int p = gt; p < 4097 + 4112; p += NGT) {
        const bool isA = p < 4097; const int pos = isA ? p : p - 4097; float* dst = (isA ? TA : TB) + (size_t)pos * 64;
        for (int i = 0; i < 32; ++i) {
            float ang;
            if (isA) ang = pos == 4096 ? 0.f : (i < 16 ? (float)(pos >> 6) * A.inv.a[i] : (float)(pos & 63) * A.inv.a[i - 16]);
            else ang = (float)pos * A.inv.b[i];
            float c, s; rope_cs(ang, c, s); dst[2 * i] = c; dst[2 * i + 1] = s;
        }
    }
    if (gw < 4) ((float*)(ws + WS_GT))[gw * 64 + lane] = A.in[4 + gw][lane];
    for (int i = gt; i < NTOK; i += NGT) ss2[i] = 0.f;
    {   bf16_t *KA = (bf16_t*)(ws + WS_KA), *VA = (bf16_t*)(ws + WS_VA), *KB = (bf16_t*)(ws + WS_KB), *VB = (bf16_t*)(ws + WS_VB);
        const v4u z = (v4u){0u, 0u, 0u, 0u};
        for (int i = gt; i < (16 + 64) * 384; i += NGT) { const int g = i / 384, e = i % 384, c = e / 48, k = 16 + e % 48;
            bf16_t* base = g < 16 ? KA + (size_t)g * 65 * 4096 : KB + (size_t)(g - 16) * 65 * 4096; *(GAS v4u*)(base + c * 512 + k * 8) = z; }
        for (int i = gt; i < 16 * 2 * 192 + 32 * 4 * 192; i += NGT) {
            if (i < 16 * 2 * 192) { const int g = i / 384, e = i % 384, db = e / 192, q = e % 192; *(GAS v4u*)(VA + (size_t)g * 65 * 4096 + db * 2048 + 16 * 32 + q * 8) = z; }
            else { const int i2 = i - 16 * 2 * 192, g = i2 / 768, e = i2 % 768, db = e / 192, q = e % 192; *(GAS v4u*)(VB + (size_t)g * 65 * 8192 + db * 2048 + 16 * 32 + q * 8) = z; }
        }
    }
}

__global__ void __launch_bounds__(NWAVES * 64, 2) mega_fwd(Args args) {
    extern __shared__ __attribute__((aligned(16))) unsigned char lds_raw[];
    LAS unsigned char* lds = (LAS unsigned char*)lds_raw;
    volatile LAS unsigned* MISC = (volatile LAS unsigned*)(lds + MISC_OFF);
    const int tid = threadIdx.x, lane = tid & 63, wave = __builtin_amdgcn_readfirstlane(tid >> 6);
    const int G = gridDim.x; const int bx = blockIdx.x; const int vcu = (G % 8 == 0) ? (bx % 8) * (G / 8) + bx / 8 : bx;
    unsigned char* ws = args.ws;
    gu32* ctl = (gu32*)(ws + WS_CTL);
    for (int u = tid; u < (LDS_BYTES - LDSCTL_OFF) / 4; u += NWAVES * 64) ((LAS unsigned*)(lds + LDSCTL_OFF))[u] = 0u;
    __syncthreads();
    const int lo = args.ph_lo, hi = args.ph_hi;
    const bool multi = hi - lo > 1;
    XcdBarrier bar; bar.bar = (unsigned*)(ctl + CW_BAR); bar.x = 0; bar.st = nullptr;
    if (multi) bar = xcd_barrier_post((unsigned*)(ctl + CW_BAR), MISC + 8);
#ifndef PH_MASK
#define PH_MASK 63
#endif
#define IN(k) (((PH_MASK >> (k)) & 1) && lo <= (k) && (k) < hi)
#define SEAM(k) do { if (IN(k) && IN((k) + 1)) xcd_barrier(bar); } while (0)
    bf16_t *Bt1 = (bf16_t*)(ws + WS_BT1), *Bt3 = (bf16_t*)(ws + WS_BT3), *Bt4 = (bf16_t*)(ws + WS_BT4), *Bt5 = (bf16_t*)(ws + WS_BT5), *XB = (bf16_t*)(ws + WS_XB);
    bf16_t *QA = (bf16_t*)(ws + WS_QA), *QB = (bf16_t*)(ws + WS_QB), *KA = (bf16_t*)(ws + WS_KA), *VA = (bf16_t*)(ws + WS_VA), *KB = (bf16_t*)(ws + WS_KB), *VB = (bf16_t*)(ws + WS_VB);
    bf16_t *MIX = (bf16_t*)(ws + WS_MIX), *X1B = (bf16_t*)(ws + WS_X1B), *HID = (bf16_t*)(ws + WS_HID);
    float *ss = (float*)(ws + WS_RS), *ss2 = (float*)(ws + WS_SS), *TA = (float*)(ws + WS_TA), *TB = (float*)(ws + WS_TB);

    if (IN(0)) { p0_prologue(args, lds, vcu, G, wave, lane); SEAM(0); }
    if (IN(1)) {
        pg8::Gemm g{XB, Bt1, 33024, 2304, 1024}; pg8::StaticOrder S; S.init(33024, 2304, G, bx);
        pg8::EpiProj E{ss, (const float*)(ws + WS_GT), TA, (bf16_t*)ws};
        pg8::gemm_phase<pg8::EpiProj, pg8::StaticOrder, true, true>(lds + RING_OFF, g, S, E);
        SEAM(1);
    }
    if (IN(2)) {
        att::Tensors T{QA, QB, KA, VA, KB, VB, MIX, (float*)(ws + WS_STASH), args.in[4], args.in[5], args.in[6], args.in[7], args.in[8], args.in[9], args.in[10], args.in[11], args.in[12]};
        att::phase((att::lds_ptr)(lds + RING_OFF), T, vcu, G);
        SEAM(2);
    }
    if (IN(3)) {
        pg8::Gemm g{MIX, Bt3, 32768, 1024, 1024}; pg8::StaticOrder S; S.init(32768, 1024, G, bx);
        pg8::EpiRes1 E{args.in[0], args.out, X1B, ss2};
        pg8::gemm_phase<pg8::EpiRes1, pg8::StaticOrder, true, true>(lds + RING_OFF, g, S, E);
        SEAM(3);
    }
    if (IN(4)) {
        pg8::Gemm g{X1B, Bt4, 32768, 5632, 1024}; pg8::StaticOrder S; S.init(32768, 5632, G, bx);
        pg8::EpiSwiglu E{ss2, HID};
        pg8::gemm_phase<pg8::EpiSwiglu, pg8::StaticOrder, true, true>(lds + RING_OFF, g, S, E);
        SEAM(4);
    }
    if (IN(5)) {
        pg8::Gemm g{HID, Bt5, 32768, 1024, 2816}; pg8::StaticOrder S; S.init(32768, 1024, G, bx);
        pg8::EpiRes2 E{args.out};
        pg8::gemm_phase<pg8::EpiRes2, pg8::StaticOrder, true, true>(lds + RING_OFF, g, S, E);
    }
#undef IN
#undef SEAM
}
#ifndef OPT_MASK
#define OPT_MASK 31
#endif
#ifndef FUSED
#define FUSED 1
#endif
extern "C" void kernel_launch(void* const* d_in, const int* in_sizes, int n_in, void* d_out, int out_size, void* d_ws, size_t ws_size, hipStream_t stream) {
    const float* x = (const float*)d_in[0]; const float* meta = (const float*)d_in[1]; const float* g1 = (const float*)d_in[2]; const float* w_in = (const float*)d_in[3];
    const float* gqa = (const float*)d_in[4]; const float* gka = (const float*)d_in[5]; const float* gqb = (const float*)d_in[6]; const float* gkb = (const float*)d_in[7];
    const float* lq1 = (const float*)d_in[8]; const float* lk1 = (const float*)d_in[9]; const float* lq2 = (const float*)d_in[10]; const float* lk2 = (const float*)d_in[11];
    const float* subg = (const float*)d_in[12]; const float* w_out = (const float*)d_in[13]; const float* g2 = (const float*)d_in[14];
    const float* w_gate = (const float*)d_in[15]; const float* w_up = (const float*)d_in[16]; const float* w_down = (const float*)d_in[17];
    float* out = (float*)d_out; unsigned char* ws = (unsigned char*)d_ws;
    if (n_in != 18 || ws_size < WS_END || out_size != NTOK * DM) { fprintf(stderr, "kernel_launch: unexpected shapes (n_in %d, ws %zu, out %d)\n", n_in, ws_size, out_size); return; }
    float* rs = (float*)(ws + WS_RS); float* ss2 = (float*)(ws + WS_SS);
    bf16_t *QA = (bf16_t*)(ws + WS_QA), *QB = (bf16_t*)(ws + WS_QB), *KA = (bf16_t*)(ws + WS_KA), *VA = (bf16_t*)(ws + WS_VA), *KB = (bf16_t*)(ws + WS_KB), *VB = (bf16_t*)(ws + WS_VB);
    bf16_t *MIX = (bf16_t*)(ws + WS_MIX), *X1B = (bf16_t*)(ws + WS_X1B), *HID = (bf16_t*)(ws + WS_HID);
    float* projf = (float*)(ws + WS_PROJF); float* OA = (float*)(ws + WS_NAIVE); float* OB = OA + (size_t)64 * SEQ * 64;
    RopeInv inv;
    for (int i = 0; i < 16; ++i) inv.a[i] = (float)pow(10000.0, -(double)(2 * i) / 32.0);
    for (int i = 0; i < 32; ++i) inv.b[i] = (float)pow(10000.0, -(double)(2 * i) / 64.0);
    static int grid = 0;
    if (grid == 0) {
        int dev = 0, cus = 0, per_cu = 0;
        if (hipGetDevice(&dev) != hipSuccess || hipDeviceGetAttribute(&cus, hipDeviceAttributeMultiprocessorCount, dev) != hipSuccess) { fprintf(stderr, "kernel_launch: device query failed\n"); grid = -1; return; }
        if (hipFuncSetAttribute((const void*)mega_fwd, hipFuncAttributeMaxDynamicSharedMemorySize, LDS_BYTES) != hipSuccess) { fprintf(stderr, "kernel_launch: hipFuncSetAttribute failed\n"); grid = -1; return; }
        if (hipOccupancyMaxActiveBlocksPerMultiprocessor(&per_cu, (const void*)mega_fwd, NWAVES * 64, LDS_BYTES) != hipSuccess || per_cu < 1) { fprintf(stderr, "kernel_launch: occupancy query says %d blocks/CU\n", per_cu); per_cu = 1; }
        (void)hipGetLastError();
        grid = cus * 1;
    }
    if (grid < 0) return;
    Args a{};
    for (int i = 0; i < 18; ++i) a.in[i] = (const float*)d_in[i];
    a.out = out; a.ws = ws; a.inv = inv;
    const int NR = NTOK + NMETA;
    if (OPT_MASK) (void)hipMemsetAsync(ws + WS_CTL, 0, CTL_ZERO_BYTES, stream);
#define MEGA(lo_, hi_) do { a.ph_lo = (lo_); a.ph_hi = (hi_); hipLaunchKernelGGL(mega_fwd, dim3(grid), dim3(NWAVES * 64), LDS_BYTES, stream, a); } while (0)
    if (FUSED && OPT_MASK == 31) { MEGA(0, 6); return; }
    if (OPT_MASK) MEGA(0, 1);
    if (OPT_MASK & 1) MEGA(1, 2);
    else {
        nk_rowss<<<(NR + 3) / 4, 256, 0, stream>>>(x, meta, rs, NR);
        nk_zero_pads<<<(112 * 48 * 128) / 256, 256, 0, stream>>>(KA, VA, KB, VB);
        for (int half = 0; half < 2; ++half) {
            nk_gemm<1, AL1, WL1, EP1><<<dim3(18, (NR + 63) / 64), 256, 0, stream>>>(NR, 1152, DM, AL1{x, meta, rs, g1}, WL1{w_in, half * 1152}, EP1{projf});
            nk_epi1<<<(NR * 18 + 255) / 256, 256, 0, stream>>>(projf, half * 18, inv, gqa, gka, gqb, gkb, QA, KA, VA, QB, KB, VB);
        }
    }
    if (OPT_MASK & 2) MEGA(2, 3);
    else {
        nk_attn<<<dim3(16, 64), 256, 0, stream>>>(QA, KA, VA, OA, gqa, gka, 0);
        nk_attn<<<dim3(16, 128), 256, 0, stream>>>(QB, KB, VB, OB, gqb, gkb, 1);
        nk_mix<<<(NTOK * 12 + 255) / 256, 256, 0, stream>>>(OA, OB, MIX, lq1, lk1, lq2, lk2, subg);
    }
    if (OPT_MASK & 4) MEGA(3, 4);
    else {
        nk_gemm<1, AL3, WLp, EP3><<<dim3(16, NTOK / 64), 256, 0, stream>>>(NTOK, DM, DM, AL3{MIX, DM}, WLp{w_out, DM}, EP3{x, out, X1B});
        nk_rowss<<<NTOK / 4, 256, 0, stream>>>(out, nullptr, ss2, NTOK);
    }
    if (OPT_MASK & 8) MEGA(4, 5);
    else nk_gemm<2, AL4, WL4, EP4><<<dim3(DFF / 64, NTOK / 64), 256, 0, stream>>>(NTOK, DFF, DM, AL4{out, ss2, g2}, WL4{w_gate, w_up}, EP4{HID});
    if (OPT_MASK & 16) MEGA(5, 6);
    else nk_gemm<1, AL3, WLp, EP5><<<dim3(16, NTOK / 64), 256, 0, stream>>>(NTOK, DM, DFF, AL3{HID, DFF}, WLp{w_down, DM}, EP5{out});
#undef MEGA
}
```

```cpp
#define X1_BF16 1
#define XRES_BF16 1
#define NT_OUT 1
#define NT_HID 1
#include <hip/hip_runtime.h>
#include <cstdint>
#include <cstdio>
#include <cmath>

typedef unsigned short bf16_t;
namespace cfg {
constexpr int NB = 8, SEQ = 4096, NMETA = 16, DM = 1024, NTOK = NB * SEQ;
constexpr int INW = 2304, DFF = 2816, NT_KV = 65;
constexpr float EPS = 1e-6f, LOG2E = 1.4426950408889634f, C2 = 0.125f * LOG2E;
constexpr float LAM_INIT = 0.2f;
constexpr size_t MiB = 1u << 20;
constexpr size_t WS_CTL = 0, WS_RS = 1 * MiB, WS_SS = 1 * MiB + 256 * 1024;
constexpr size_t WS_GT = 1 * MiB + 448 * 1024;
constexpr size_t WS_TA = 2 * MiB, WS_TB = 4 * MiB, WS_BT1 = 6 * MiB, WS_BT3 = 11 * MiB, WS_BT4 = 13 * MiB, WS_BT5 = 24 * MiB;
constexpr size_t WS_XB = 32 * MiB;
constexpr size_t WS_QA = WS_XB + 33024ull * 2048;
constexpr size_t WS_QB = WS_QA + 32 * MiB;
constexpr size_t WS_KA = WS_QB + 32 * MiB;
constexpr size_t WS_VA = WS_KA + 16ull * NT_KV * 8192;
constexpr size_t WS_KB = WS_VA + 16ull * NT_KV * 8192;
constexpr size_t WS_VB = WS_KB + 64ull * NT_KV * 8192;
constexpr size_t WS_REND = WS_VB + 32ull * NT_KV * 16384;
constexpr size_t WS_HID = 32 * MiB;
constexpr size_t WS_MIX = 242 * MiB, WS_X1B = 306 * MiB, WS_STASH = 370 * MiB, WS_NAIVE = 306 * MiB, WS_PROJF = 242 * MiB, WS_END = 512 * MiB;
static_assert(WS_REND <= WS_MIX && WS_HID + 32768ull * DFF * 2 <= WS_MIX, "ws map");
}
using namespace cfg;

__host__ __device__ __forceinline__ unsigned f2bf(float f) { unsigned u = __builtin_bit_cast(unsigned, f); return (u + 0x7fffu + ((u >> 16) & 1u)) >> 16; }
__host__ __device__ __forceinline__ float bf2f(bf16_t h) { return __builtin_bit_cast(float, (unsigned)h << 16); }
__host__ __device__ __forceinline__ size_t kidx(int grp, int krow, int d) { return ((size_t)grp * NT_KV + (krow >> 6)) * 4096 + (d >> 3) * 512 + (krow & 63) * 8 + (d & 7); }
__host__ __device__ __forceinline__ size_t vidx(int grp, int krow, int d, int ndb) { return ((size_t)grp * NT_KV + (krow >> 6)) * (size_t)(ndb * 2048) + (d >> 5) * 2048 + (krow & 63) * 32 + (d & 31); }

struct RopeInv { float a[16]; float b[32]; };
__device__ __forceinline__ void rope_cs(float ang, float& c, float& s) {
    double rev = (double)ang * 0.15915494309189535; rev -= floor(rev); const float r = (float)rev;
    c = __builtin_amdgcn_cosf(r); s = __builtin_amdgcn_sinf(r);
}

#ifndef PG8_WGM
#define PG8_WGM 8
#endif
namespace pg8 {
#define PG8_LAS __attribute__((address_space(3)))
typedef unsigned short bf16_t;
typedef short bf16x8 __attribute__((ext_vector_type(8)));
typedef float f32x4 __attribute__((ext_vector_type(4)));
typedef unsigned u32x4 __attribute__((ext_vector_type(4)));
constexpr int BM = 256, BK = 64, HALF = 128, HTB = HALF * BK * 2  , STAGE_BYTES = 8 * HTB, NXCD = 8, WGM = PG8_WGM;

__host__ __device__ __forceinline__ int lds_byte(int r, int c) { const int st = (r >> 4) * 2 + (c >> 5), rr = r & 15, cc = c & 31, ob = rr * 64 + cc * 2; return st * 1024 + (ob ^ (((ob >> 9) & 1) << 5)); }
__host__ __device__ __forceinline__ void stage_rc(int b, int& R, int& C) { const int st = b / 1024, sb = b % 1024, swz = sb ^ (((sb >> 9) & 1) << 5); R = (st >> 1) * 16 + swz / 64; C = (st & 1) * 32 + (swz % 64) / 2; }
__host__ __device__ __forceinline__ int perm32(int rho) { const int n = rho >> 4, i = rho & 15; return 8 * (i >> 2) + 4 * n + (i & 3); }

struct Unit { int pm, pn; };
struct Gemm { const bf16_t* A; const bf16_t* Bt; int M, N, K; };

struct StaticOrder {
    int nM, nN, nwg, G, c;
    __host__ __device__ void init(int M, int N, int G_, int c_) { nM = M / BM; nN = N / BM; nwg = nM * nN; G = G_; c = c_; }
    __host__ __device__ bool next(int i, Unit& u) const {
        const long L = (long)i * G + c; if (L >= nwg) return false;
        int wgid = (int)L; { const int q = nwg / NXCD, r = nwg % NXCD, xcd = wgid % NXCD, off = wgid / NXCD; wgid = (xcd < r ? xcd * (q + 1) : r * (q + 1) + (xcd - r) * q) + off; }
        const int nig = WGM * nN, gid = wgid / nig, fm = gid * WGM, gsz = (nM - fm) < WGM ? (nM - fm) : WGM;
        u.pm = fm + ((wgid % nig) % gsz); u.pn = (wgid % nig) / gsz; return true;
    }
    __device__ __forceinline__ void a_ready(const Unit&) const {}
    __device__ __forceinline__ void done(const Unit&) const {}
};

__device__ __forceinline__ unsigned cvt_pk_bf16(float lo, float hi) { unsigned r; asm volatile("v_cvt_pk_bf16_f32 %0, %1, %2" : "=v"(r) : "v"(lo), "v"(hi)); return r; }

#ifndef NT_QKV
#define NT_QKV 0
#endif
#ifndef NT_X1B
#define NT_X1B 0
#endif
#define PG8_ST16(p, v, NT) do { if (NT) __builtin_nontemporal_store((v), (u32x4*)(p)); else *(u32x4*)(p) = (v); } while (0)
struct EpiProj {
    static constexpr bool PERM = true, AFTER_DRAIN = false; static constexpr int NST = 0;
    const float* ss; const float* GT; const float* TAB; bf16_t* wsb;
    static constexpr size_t TBOFF = (WS_TB - WS_TA) / 4, O_QA = WS_QA / 2, O_QB = WS_QB / 2, O_KA = WS_KA / 2, O_VA = WS_VA / 2, O_KB = WS_KB / 2, O_VB = WS_VB / 2;
    __device__ __forceinline__ void operator()(const f32x4 (&acc)[2][2][4][2], const Unit& u, int wr, int wc, int fr_, int fq_) const {
        int fr = fr_, fq = fq_; asm volatile("" : "+v"(fr), "+v"(fq));
        const int slot = u.pn * 4 + wc; const bool metaT = (u.pm == 128);
        int type, hh;
        if (slot < 8) { type = 0; hh = slot; } else if (slot < 10) { type = 1; hh = slot - 8; } else if (slot < 12) { type = 2; hh = slot - 10; }
        else if (slot < 20) { type = 3; hh = slot - 12; } else if (slot < 28) { type = 4; hh = slot - 20; } else { type = 5; hh = slot - 28; }
        if (metaT && (type == 0 || type == 3)) return;
        const bool isB = type >= 3, normed = (type != 2 && type != 5), isQ = (type == 0 || type == 3);
        const int gi = type == 0 ? 0 : type == 1 ? 1 : type == 3 ? 2 : 3;
        f32x4 gv[2][2];
#pragma unroll
        for (int bj = 0; bj < 2; ++bj)
#pragma unroll
            for (int n = 0; n < 2; ++n) gv[bj][n] = *(const f32x4*)(GT + gi * 64 + 32 * bj + 8 * fq + 4 * n);
        const int b = u.pm >> 4, tbase = (u.pm & 15) * 256;
        size_t obase, bstride; int tilesz;
        if (type == 0)      { obase = O_QA + (size_t)hh * 4096 * 64; bstride = (size_t)8 * 4096 * 64; tilesz = 0; }
        else if (type == 3) { obase = O_QB + (size_t)hh * 4096 * 64; bstride = (size_t)8 * 4096 * 64; tilesz = 0; }
        else if (type == 1) { obase = O_KA + (size_t)hh * 65 * 4096; bstride = (size_t)2 * 65 * 4096; tilesz = 4096; }
        else if (type == 4) { obase = O_KB + (size_t)hh * 65 * 4096; bstride = (size_t)8 * 65 * 4096; tilesz = 4096; }
        else if (type == 2) { obase = O_VA + (size_t)hh * 65 * 4096; bstride = (size_t)2 * 65 * 4096; tilesz = 4096; }
        else                { obase = O_VB + (size_t)(hh >> 1) * 65 * 8192 + (size_t)((hh & 1) * 2) * 2048; bstride = (size_t)4 * 65 * 8192; tilesz = 8192; }
        const bool isK = (type == 1 || type == 4);
#pragma unroll
        for (int ai = 0; ai < 2; ++ai)
#pragma unroll
            for (int m = 0; m < 4; ++m) {
                if (metaT && (ai | m | wr)) continue;
                const int rloc = ai * 128 + wr * 64 + m * 16 + fr, row = u.pm * 256 + rloc, t = tbase + rloc;
                const float rsx = __builtin_amdgcn_rsqf(ss[row] * (1.f / 1024.f) + 1e-6f);
                f32x4 y[2][2]; float s = 0.f;
#pragma unroll
                for (int bj = 0; bj < 2; ++bj)
#pragma unroll
                    for (int n = 0; n < 2; ++n) { y[bj][n] = acc[ai][bj][m][n] * rsx; const f32x4 q = y[bj][n] * y[bj][n]; s += (q[0] + q[1]) + (q[2] + q[3]); }
                if (normed) {
                    s += __shfl_xor(s, 16); s += __shfl_xor(s, 32);
                    const float rn = __builtin_amdgcn_rsqf(s * (1.f / 64.f) + 1e-6f) * (isQ ? 0.18033688011112042f : 1.f);
                    const float* T = TAB + (isB ? TBOFF + (size_t)(metaT ? rloc : 16 + t) * 64 : (size_t)(metaT ? 4096 : t) * 64);
#pragma unroll
                    for (int bj = 0; bj < 2; ++bj)
#pragma unroll
                        for (int n = 0; n < 2; ++n) {
                            const f32x4 cs = *(const f32x4*)(T + (16 * bj + 4 * fq + 2 * n) * 2);
                            const f32x4 v = y[bj][n] * gv[bj][n] * rn;
                            y[bj][n] = (f32x4){v[0] * cs[0] - v[1] * cs[1], v[0] * cs[1] + v[1] * cs[0], v[2] * cs[2] - v[3] * cs[3], v[2] * cs[3] + v[3] * cs[2]};
                        }
                }
                u32x4 w[2];
#pragma unroll
                for (int bj = 0; bj < 2; ++bj) { w[bj].x = cvt_pk_bf16(y[bj][0][0], y[bj][0][1]); w[bj].y = cvt_pk_bf16(y[bj][0][2], y[bj][0][3]); w[bj].z = cvt_pk_bf16(y[bj][1][0], y[bj][1][1]); w[bj].w = cvt_pk_bf16(y[bj][1][2], y[bj][1][3]); }
                size_t off; int step;
                if (isQ) { off = (size_t)t * 64 + 8 * fq; step = 32; }
                else { const int krow = metaT ? rloc : 64 + t, tile = krow >> 6, key = krow & 63;
                    if (isK) { off = (size_t)tile * tilesz + fq * 512 + key * 8; step = 2048; } else { off = (size_t)tile * tilesz + key * 32 + 8 * fq; step = 2048; } }
                for (int bb = (metaT ? 0 : b); bb < (metaT ? 8 : b + 1); ++bb) { bf16_t* p = wsb + obase + (size_t)bb * bstride + off; PG8_ST16(p, w[0], NT_QKV); PG8_ST16(p + step, w[1], NT_QKV); }
                asm volatile("" ::: "memory");
            }
    }
};

struct EpiRes1 {
    static constexpr bool PERM = true, AFTER_DRAIN = false; static constexpr int NST = 16;
    const float* x; float* out; bf16_t* x1b; float* ss2; const bf16_t* xb;
    __device__ __forceinline__ void operator()(const f32x4 (&acc)[2][2][4][2], const Unit& u, int wr, int wc, int fr, int fq) const {
#pragma unroll
        for (int ai = 0; ai < 2; ++ai)
#pragma unroll
            for (int m = 0; m < 4; ++m) {
                const int row = u.pm * 256 + ai * 128 + wr * 64 + m * 16 + fr; float s = 0.f;
#pragma unroll
                for (int bj = 0; bj < 2; ++bj) {
                    const size_t off = (size_t)row * 1024 + u.pn * 256 + bj * 128 + wc * 32 + 8 * fq;
#ifdef XRES_BF16
                    const u32x4 xw = *(const u32x4*)(xb + off);
                    const f32x4 x0 = {__builtin_bit_cast(float, xw.x << 16), __builtin_bit_cast(float, xw.x & 0xffff0000u), __builtin_bit_cast(float, xw.y << 16), __builtin_bit_cast(float, xw.y & 0xffff0000u)};
                    const f32x4 x1 = {__builtin_bit_cast(float, xw.z << 16), __builtin_bit_cast(float, xw.z & 0xffff0000u), __builtin_bit_cast(float, xw.w << 16), __builtin_bit_cast(float, xw.w & 0xffff0000u)};
                    const f32x4 a0 = x0 + acc[ai][bj][m][0], a1 = x1 + acc[ai][bj][m][1];
#else
                    const f32x4 a0 = *(const f32x4*)(x + off) + acc[ai][bj][m][0], a1 = *(const f32x4*)(x + off + 4) + acc[ai][bj][m][1];
#endif
#ifndef X1_BF16
                    *(f32x4*)(out + off) = a0; *(f32x4*)(out + off + 4) = a1;
#endif
                    u32x4 w; w.x = cvt_pk_bf16(a0[0], a0[1]); w.y = cvt_pk_bf16(a0[2], a0[3]); w.z = cvt_pk_bf16(a1[0], a1[1]); w.w = cvt_pk_bf16(a1[2], a1[3]);
                    PG8_ST16(x1b + off, w, NT_X1B);
                    const f32x4 q0 = a0 * a0, q1 = a1 * a1; s += ((q0[0] + q0[1]) + (q0[2] + q0[3])) + ((q1[0] + q1[1]) + (q1[2] + q1[3]));
                }
                s += __shfl_xor(s, 16); s += __shfl_xor(s, 32);
                if (fq == 0) atomicAdd(ss2 + row, s);
            }
    }
};

struct EpiSwiglu {
    static constexpr bool PERM = true, AFTER_DRAIN = false; static constexpr int NST = 8;
    const float* ss2; bf16_t* hid;
    __device__ __forceinline__ void operator()(const f32x4 (&acc)[2][2][4][2], const Unit& u, int wr, int wc, int fr, int fq) const {
#pragma unroll
        for (int ai = 0; ai < 2; ++ai)
#pragma unroll
            for (int m = 0; m < 4; ++m) {
                const int row = u.pm * 256 + ai * 128 + wr * 64 + m * 16 + fr;
                const float r = __builtin_amdgcn_rsqf(ss2[row] * (1.f / 1024.f) + 1e-6f);
                float h[8];
#pragma unroll
                for (int n = 0; n < 2; ++n)
#pragma unroll
                    for (int i = 0; i < 4; ++i) { const float g = acc[ai][0][m][n][i] * r, uu = acc[ai][1][m][n][i] * r;
                        h[n * 4 + i] = g * __builtin_amdgcn_rcpf(1.f + __builtin_amdgcn_exp2f(-1.4426950408889634f * g)) * uu; }
                u32x4 w; w.x = cvt_pk_bf16(h[0], h[1]); w.y = cvt_pk_bf16(h[2], h[3]); w.z = cvt_pk_bf16(h[4], h[5]); w.w = cvt_pk_bf16(h[6], h[7]);
#ifdef NT_HID
                __builtin_nontemporal_store(w, (u32x4*)(hid + (size_t)row * 2816 + u.pn * 128 + wc * 32 + 8 * fq));
#else
                *(u32x4*)(hid + (size_t)row * 2816 + u.pn * 128 + wc * 32 + 8 * fq) = w;
#endif
            }
    }
};

struct EpiRes2 {
    static constexpr bool PERM = true, AFTER_DRAIN = false; static constexpr int NST = 32;
    float* out; const bf16_t* x1b;
    __device__ __forceinline__ void operator()(const f32x4 (&acc)[2][2][4][2], const Unit& u, int wr, int wc, int fr, int fq) const {
#pragma unroll
        for (int ai = 0; ai < 2; ++ai)
#pragma unroll
            for (int m = 0; m < 4; ++m) {
                const int row = u.pm * 256 + ai * 128 + wr * 64 + m * 16 + fr;
#pragma unroll
                for (int bj = 0; bj < 2; ++bj) {
                    const size_t off = (size_t)row * 1024 + u.pn * 256 + bj * 128 + wc * 32 + 8 * fq; float* p = out + off;
#ifdef X1_BF16
                    const u32x4 w = *(const u32x4*)(x1b + off);
                    const f32x4 r0 = {__builtin_bit_cast(float, w.x << 16), __builtin_bit_cast(float, w.x & 0xffff0000u), __builtin_bit_cast(float, w.y << 16), __builtin_bit_cast(float, w.y & 0xffff0000u)};
                    const f32x4 r1 = {__builtin_bit_cast(float, w.z << 16), __builtin_bit_cast(float, w.z & 0xffff0000u), __builtin_bit_cast(float, w.w << 16), __builtin_bit_cast(float, w.w & 0xffff0000u)};
#ifdef NT_OUT
                    __builtin_nontemporal_store(r0 + acc[ai][bj][m][0], (f32x4*)(p)); __builtin_nontemporal_store(r1 + acc[ai][bj][m][1], (f32x4*)(p + 4));
#else
                    *(f32x4*)(p) = r0 + acc[ai][bj][m][0]; *(f32x4*)(p + 4) = r1 + acc[ai][bj][m][1];
#endif
#else
                    *(f32x4*)(p) = *(const f32x4*)(p) + acc[ai][bj][m][0]; *(f32x4*)(p + 4) = *(const f32x4*)(p + 4) + acc[ai][bj][m][1];
#endif
                }
            }
    }
};
#ifndef SEAM_DEFER
#define SEAM_DEFER 1
#endif
template <class Epi, class Sched, bool ALIGN_EPI = false, bool SP2 = false>
__device__ __forceinline__ void gemm_phase(PG8_LAS unsigned char* lds, const Gemm g, const Sched& S, const Epi& E) {
    const int tid = threadIdx.x, wid = __builtin_amdgcn_readfirstlane(tid >> 6), lane = tid & 63, wr = wid >> 2, wc = wid & 3, fr = lane & 15, fq = lane >> 4;
    const int K = g.K, nt = K / BK;
    unsigned voffA[2], voffB[2];
#pragma unroll
    for (int i = 0; i < 2; ++i) { int R, C; stage_rc(tid * 16 + i * 8192, R, C); const int Rb = Epi::PERM ? ((R & ~31) + perm32(R & 31)) : R;
        voffA[i] = (unsigned)(R * K + C) * 2u; voffB[i] = (unsigned)(Rb * K + C) * 2u; }
    const size_t kstep = (size_t)(BK * 2);
    const size_t hstep = (size_t)HALF * K * 2;
    const size_t tstep = 2 * hstep;
    const unsigned ldsw = (unsigned)wid * 1024u;
    const int aoff = lds_byte(wr * 64 + fr, fq * 8), boff = lds_byte(wc * 32 + fr, fq * 8);
#define PG8_SA(b, h) (((b) * 2 + (h)) * HTB)
#define PG8_SB(b, h) ((4 + (b) * 2 + (h)) * HTB)
#define PG8_STAGE(bufoff, gbase, voff) do { _Pragma("unroll") for (int _i = 0; _i < 2; ++_i) \
        __builtin_amdgcn_global_load_lds((const unsigned*)((const char*)(gbase) + (voff)[_i]), (PG8_LAS unsigned*)(lds + (bufoff) + ldsw + _i * 8192), 16, 0, 0); } while (0)
#define PG8_LDA(dst, b, h) do { _Pragma("unroll") for (int m = 0; m < 4; ++m) _Pragma("unroll") for (int k = 0; k < 2; ++k) dst[m][k] = *(const PG8_LAS bf16x8*)(lds + PG8_SA(b, h) + aoff + m * 2048 + k * 1024); } while (0)
#define PG8_LDB(dst, b, h) do { _Pragma("unroll") for (int n = 0; n < 2; ++n) _Pragma("unroll") for (int k = 0; k < 2; ++k) dst[n][k] = *(const PG8_LAS bf16x8*)(lds + PG8_SB(b, h) + boff + n * 2048 + k * 1024); } while (0)
#define PG8_MMA(ai, bj, At, Bt) do { __builtin_amdgcn_s_setprio(1); _Pragma("unroll") for (int m = 0; m < 4; ++m) _Pragma("unroll") for (int n = 0; n < 2; ++n) _Pragma("unroll") for (int k = 0; k < 2; ++k) \
        acc[ai][bj][m][n] = __builtin_amdgcn_mfma_f32_16x16x32_bf16(Bt[n][k], At[m][k], acc[ai][bj][m][n], 0, 0, 0); __builtin_amdgcn_s_setprio(0); } while (0)
#define PG8_WAIT_V(n) asm volatile("s_waitcnt vmcnt(" #n ")" ::: "memory")
#define PG8_SEAM_ASM(N) asm volatile("s_waitcnt vmcnt(" #N ")\n\ts_cmp_lg_u32 %0, 0\n\ts_cbranch_scc1 .Lpgsk%=\n\ts_waitcnt vmcnt(8)\n.Lpgsk%=:" :: "s"(seamf) : "memory", "scc")
#define PG8_WAIT_SEAM() do { if constexpr (!SEAM_DEFER || Epi::NST == 0) PG8_WAIT_V(8); else if constexpr (Epi::NST == 32) PG8_SEAM_ASM(40); else if constexpr (Epi::NST == 16) PG8_SEAM_ASM(24); else PG8_SEAM_ASM(16); } while (0)
#define PG8_WAIT_L(n) asm volatile("s_waitcnt lgkmcnt(" #n ")" ::: "memory")
#define PG8_BAR __builtin_amdgcn_s_barrier()
#define PG8_SCHED __builtin_amdgcn_sched_barrier(0)
    Unit cur, nxt; int ui = 0;
    if (!S.next(0, cur)) return;
    f32x4 acc[2][2][4][2];
#pragma unroll
    for (int a = 0; a < 2; ++a)
#pragma unroll
        for (int b = 0; b < 2; ++b)
#pragma unroll
            for (int m = 0; m < 4; ++m)
#pragma unroll
                for (int n = 0; n < 2; ++n) acc[a][b][m][n] = (f32x4){0.f, 0.f, 0.f, 0.f};
    bf16x8 At[4][2], B0[2][2], B1[2][2];
    const char* cA = (const char*)g.A + (size_t)cur.pm * tstep; const char* cB = (const char*)g.Bt + (size_t)cur.pn * tstep;
    S.a_ready(cur);
    if constexpr (SP2) {
        PG8_STAGE(PG8_SB(0, 0), cB, voffB); PG8_STAGE(PG8_SB(0, 1), cB + hstep, voffB); PG8_STAGE(PG8_SA(0, 0), cA, voffA); PG8_STAGE(PG8_SA(0, 1), cA + hstep, voffA);
        if (wr == 1) PG8_BAR;
        PG8_WAIT_V(2); PG8_BAR;
        PG8_STAGE(PG8_SB(1, 0), cB + kstep, voffB); PG8_STAGE(PG8_SA(1, 0), cA + kstep, voffA); PG8_STAGE(PG8_SB(1, 1), cB + hstep + kstep, voffB);
        PG8_WAIT_V(6); PG8_BAR;
    } else {
        PG8_STAGE(PG8_SB(0, 0), cB, voffB); PG8_STAGE(PG8_SA(0, 0), cA, voffA); PG8_STAGE(PG8_SB(0, 1), cB + hstep, voffB); PG8_STAGE(PG8_SA(0, 1), cA + hstep, voffA);
        if (wr == 1) PG8_BAR;
        PG8_WAIT_V(4); PG8_BAR;
        PG8_STAGE(PG8_SB(1, 0), cB + kstep, voffB); PG8_STAGE(PG8_SA(1, 0), cA + kstep, voffA); PG8_STAGE(PG8_SB(1, 1), cB + hstep + kstep, voffB);
        PG8_WAIT_V(6); PG8_BAR;
    }
    for (;;) {
        const bool has_next = S.next(ui + 1, nxt);
        const char* nA = has_next ? (const char*)g.A + (size_t)nxt.pm * tstep : cA; const char* nB = has_next ? (const char*)g.Bt + (size_t)nxt.pn * tstep : cB;
        for (int t = 0; t < nt; t += 2) {
            const bool last = (t == nt - 2);
            const int seamf = __builtin_amdgcn_readfirstlane((t == 0 && ui > 0) ? 1 : 0);
            const char* a1 = cA + (size_t)(t + 1) * kstep;
            const char* a2 = last ? nA : cA + (size_t)(t + 2) * kstep; const char* b2 = last ? nB : cB + (size_t)(t + 2) * kstep;
            const char* a3 = a2 + kstep; const char* b3 = b2 + kstep;
            if (last && has_next) S.a_ready(nxt);
            if constexpr (SP2) {
            PG8_LDB(B0, 0, 0); PG8_LDB(B1, 0, 1); PG8_SCHED; PG8_LDA(At, 0, 0); PG8_STAGE(PG8_SA(1, 1), a1 + hstep, voffA);
            PG8_WAIT_SEAM(); PG8_WAIT_L(0); PG8_BAR; PG8_MMA(0, 0, At, B0); PG8_MMA(0, 1, At, B1); PG8_BAR; PG8_SCHED;
            PG8_LDA(At, 0, 1); PG8_STAGE(PG8_SB(0, 0), b2, voffB); PG8_STAGE(PG8_SB(0, 1), b2 + hstep, voffB); PG8_STAGE(PG8_SA(0, 0), a2, voffA);
            PG8_WAIT_SEAM(); PG8_WAIT_L(0); PG8_BAR; PG8_MMA(1, 0, At, B0); PG8_MMA(1, 1, At, B1); PG8_BAR; PG8_SCHED;
            PG8_LDB(B0, 1, 0); PG8_LDB(B1, 1, 1); PG8_SCHED; PG8_LDA(At, 1, 0); PG8_STAGE(PG8_SA(0, 1), a2 + hstep, voffA);
            PG8_WAIT_V(8); PG8_WAIT_L(0); PG8_BAR; PG8_MMA(0, 0, At, B0); PG8_MMA(0, 1, At, B1); PG8_BAR; PG8_SCHED;
            PG8_LDA(At, 1, 1); PG8_STAGE(PG8_SB(1, 0), b3, voffB); PG8_STAGE(PG8_SB(1, 1), b3 + hstep, voffB); PG8_STAGE(PG8_SA(1, 0), a3, voffA);
            PG8_WAIT_V(8); PG8_WAIT_L(0); PG8_BAR; PG8_MMA(1, 0, At, B0); PG8_MMA(1, 1, At, B1); PG8_BAR; PG8_SCHED;
            } else {
            PG8_LDB(B0, 0, 0); PG8_SCHED; PG8_LDA(At, 0, 0); PG8_STAGE(PG8_SA(1, 1), a1 + hstep, voffA);
            PG8_WAIT_L(8); PG8_BAR; PG8_WAIT_L(0); PG8_MMA(0, 0, At, B0); PG8_BAR; PG8_SCHED;
            PG8_LDB(B1, 0, 1); PG8_STAGE(PG8_SB(0, 0), b2, voffB);
            PG8_BAR; PG8_WAIT_L(0); PG8_MMA(0, 1, At, B1); PG8_BAR;
            PG8_LDA(At, 0, 1); PG8_STAGE(PG8_SA(0, 0), a2, voffA);
            PG8_BAR; PG8_WAIT_L(0); PG8_MMA(1, 0, At, B0); PG8_BAR; PG8_SCHED;
            PG8_STAGE(PG8_SB(0, 1), b2 + hstep, voffB);
            PG8_WAIT_V(6); PG8_BAR; PG8_MMA(1, 1, At, B1); PG8_BAR;
            PG8_LDB(B0, 1, 0); PG8_SCHED; PG8_LDA(At, 1, 0); PG8_STAGE(PG8_SA(0, 1), a2 + hstep, voffA);
            PG8_WAIT_L(8); PG8_BAR; PG8_WAIT_L(0); PG8_MMA(0, 0, At, B0); PG8_BAR; PG8_SCHED;
            PG8_LDB(B1, 1, 1); PG8_STAGE(PG8_SB(1, 0), b3, voffB);
            PG8_BAR; PG8_WAIT_L(0); PG8_MMA(0, 1, At, B1); PG8_BAR;
            PG8_LDA(At, 1, 1); PG8_STAGE(PG8_SA(1, 0), a3, voffA);
            PG8_BAR; PG8_WAIT_L(0); PG8_MMA(1, 0, At, B0); PG8_BAR; PG8_SCHED;
            PG8_STAGE(PG8_SB(1, 1), b3 + hstep, voffB);
            PG8_WAIT_V(6); PG8_BAR; PG8_MMA(1, 1, At, B1); PG8_BAR;
            }
        }
        if constexpr (ALIGN_EPI) { if (wr == 0) PG8_BAR; }
        if constexpr (!Epi::AFTER_DRAIN) { E(acc, cur, wr, wc, fr, fq); S.done(cur); }
        if (!has_next) break;
#pragma unroll
        for (int a = 0; a < 2; ++a)
#pragma unroll
            for (int b = 0; b < 2; ++b)
#pragma unroll
                for (int m = 0; m < 4; ++m)
#pragma unroll
                    for (int n = 0; n < 2; ++n) acc[a][b][m][n] = (f32x4){0.f, 0.f, 0.f, 0.f};
        cur = nxt; cA = nA; cB = nB; ++ui;
        if constexpr (ALIGN_EPI) { if (wr == 1) PG8_BAR; }
    }
    PG8_WAIT_V(0);
    if constexpr (!ALIGN_EPI) { if (wr == 0) PG8_BAR; }
    PG8_BAR;
    if constexpr (Epi::AFTER_DRAIN) { E.fused(acc, cur, wr, wc, fr, fq, lds, wid, lane); S.done(cur); }
#undef PG8_SA
#undef PG8_SB
#undef PG8_STAGE
#undef PG8_LDA
#undef PG8_LDB
#undef PG8_MMA
#undef PG8_WAIT_V
#undef PG8_WAIT_SEAM
#undef PG8_SEAM_ASM
#undef PG8_WAIT_L
#undef PG8_BAR
#undef PG8_SCHED
}
}
namespace att {
using bf16x8 = __attribute__((ext_vector_type(8))) short;
using s16x4 = __attribute__((ext_vector_type(4))) short;
using f32x16 = __attribute__((ext_vector_type(16))) float;
using u32x4 = __attribute__((ext_vector_type(4))) unsigned;
typedef short v4i16_t __attribute__((ext_vector_type(4)));
typedef __attribute__((address_space(3))) const char* lds_cptr;
typedef __attribute__((address_space(3))) char* lds_ptr;
constexpr int L_K = 0, L_V = 24576, L_WS = 73728, L_OST = 75776, L_END = L_OST + 8 * 8192;
__device__ __forceinline__ int crow(int r, int hi) { return (r & 3) + 8 * (r >> 2) + 4 * hi; }
__device__ __forceinline__ unsigned cvtpk(float lo, float hi) { unsigned r; asm volatile("v_cvt_pk_bf16_f32 %0, %1, %2" : "=v"(r) : "v"(lo), "v"(hi)); return r; }
__device__ __forceinline__ s16x4 vtr(lds_cptr p) { return __builtin_bit_cast(s16x4, __builtin_amdgcn_ds_read_tr16_b64_v4i16((__attribute__((address_space(3))) v4i16_t*)p)); }
__device__ __forceinline__ float fadd_s(float a, float b) { float r; asm("v_add_f32_e32 %0, %1, %2" : "=v"(r) : "v"(a), "v"(b)); return r; }
__device__ __forceinline__ float wave_max(float v) { for (int o = 1; o < 64; o <<= 1) v = fmaxf(v, __shfl_xor(v, o)); return v; }
__device__ __forceinline__ float wave_sum(float v) { for (int o = 1; o < 64; o <<= 1) v += __shfl_xor(v, o); return v; }

#define AT_SB() __builtin_amdgcn_sched_barrier(0)
__device__ __forceinline__ void vload4(bf16x8 (&vf)[4], lds_cptr vp) {
#pragma unroll
    for (int ks = 0; ks < 4; ++ks) { const s16x4 lo = vtr(vp + ks * 1024), hi4 = vtr(vp + ks * 1024 + 512); vf[ks] = (bf16x8){lo[0], lo[1], lo[2], lo[3], hi4[0], hi4[1], hi4[2], hi4[3]}; }
}
#ifndef RING_DEPTH
#define RING_DEPTH 4
#endif
#ifndef NPRE2
#define NPRE2 0
#endif
#ifndef NPRE4
#define NPRE4 0
#endif
__device__ __forceinline__ void vload1(bf16x8& vf, lds_cptr vp, int i) { const s16x4 lo = vtr(vp + (i >> 2) * 4096 + (i & 3) * 1024), hi4 = vtr(vp + (i >> 2) * 4096 + (i & 3) * 1024 + 512); vf = (bf16x8){lo[0], lo[1], lo[2], lo[3], hi4[0], hi4[1], hi4[2], hi4[3]}; }
template <int NDB, bool HASPV, bool HASQK>
__device__ __forceinline__ void phase1(lds_cptr vp, const u32x4 (&pw)[4], f32x16 (&o)[NDB], const bf16x8 (&qr)[4], f32x16& c0, f32x16& c1, const bf16x8 (&kf)[8], const bf16x8 (&vf)[8]) {
    constexpr int NPRE = (NDB == 2) ? NPRE2 : NPRE4;
    constexpr int RD = RING_DEPTH;
    bf16x8 vr[RD];
    if (HASPV && NPRE < 4 * NDB) {
#pragma unroll
        for (int i = 0; i < RD; ++i) vload1(vr[i], vp, NPRE + i);
        AT_SB();
    }
    if (HASQK) {
        const f32x16 z = {0.f, 0.f, 0.f, 0.f, 0.f, 0.f, 0.f, 0.f, 0.f, 0.f, 0.f, 0.f, 0.f, 0.f, 0.f, 0.f};
        f32x16 n0 = z, n1 = z;
        if (!HASPV) {
#pragma unroll
            for (int r = 0; r < 16; ++r) { n0[r] = (r < 8) ? 0.f : -30000.f; n1[r] = -30000.f; }
        }
#pragma unroll
        for (int d0 = 0; d0 < 4; ++d0) {
            c0 = __builtin_amdgcn_mfma_f32_32x32x16_bf16(kf[2 * d0], qr[d0], d0 == 0 ? n0 : c0, 0, 0, 0);
            c1 = __builtin_amdgcn_mfma_f32_32x32x16_bf16(kf[2 * d0 + 1], qr[d0], d0 == 0 ? n1 : c1, 0, 0, 0);
        }
        AT_SB();
    }
    if (HASPV) {
#pragma unroll
        for (int i = 0; i < 4 * NDB; ++i) {
            if (i < NPRE) o[i >> 2] = __builtin_amdgcn_mfma_f32_32x32x16_bf16(__builtin_bit_cast(bf16x8, pw[i & 3]), vf[i & 7], o[i >> 2], 0, 0, 0);
            else { o[i >> 2] = __builtin_amdgcn_mfma_f32_32x32x16_bf16(__builtin_bit_cast(bf16x8, pw[i & 3]), vr[(i - NPRE) % RD], o[i >> 2], 0, 0, 0);
                   if (i + RD < 4 * NDB) vload1(vr[(i - NPRE) % RD], vp, i + RD); AT_SB(); }
        }
    }
}
__device__ __forceinline__ void softmax_tile(f32x16& c0, f32x16& c1, float& l, u32x4 (&pw)[4]) {
#ifdef SUM_PK
    { float sa = 0.f, sb = 0.f;
#pragma unroll
      for (int r = 0; r < 16; ++r) { c0[r] = __builtin_amdgcn_exp2f(c0[r]); c1[r] = __builtin_amdgcn_exp2f(c1[r]); sa += c0[r]; sb += c1[r]; }
      l += sa + sb; }
#else
#pragma unroll
    for (int r = 0; r < 16; ++r) { c0[r] = __builtin_amdgcn_exp2f(c0[r]); c1[r] = __builtin_amdgcn_exp2f(c1[r]); l += c0[r]; l += c1[r]; }
#endif
#ifdef PROBE_DUP_VALU
    { float dz = 0.f;
#pragma unroll
      for (int r = 0; r < 16; ++r) { dz += __builtin_amdgcn_exp2f(c0[r]); dz += __builtin_amdgcn_exp2f(c1[r]); }
      asm volatile("" :: "v"(dz)); }
#endif
#pragma unroll
    for (int k = 0; k < 2; ++k) {
        pw[k] = (u32x4){cvtpk(c0[8 * k + 0], c0[8 * k + 1]), cvtpk(c0[8 * k + 2], c0[8 * k + 3]), cvtpk(c0[8 * k + 4], c0[8 * k + 5]), cvtpk(c0[8 * k + 6], c0[8 * k + 7])};
        pw[2 + k] = (u32x4){cvtpk(c1[8 * k + 0], c1[8 * k + 1]), cvtpk(c1[8 * k + 2], c1[8 * k + 3]), cvtpk(c1[8 * k + 4], c1[8 * k + 5]), cvtpk(c1[8 * k + 6], c1[8 * k + 7])};
    }
}
__device__ __forceinline__ void glds16(const void* gsrc, unsigned lds_dst) { unsigned keep;
    asm volatile("s_mov_b32 %0, m0\n\ts_mov_b32 m0, %2\n\ts_nop 0\n\tglobal_load_lds_dwordx4 %1, off\n\ts_mov_b32 m0, %0" : "=&s"(keep) : "v"(gsrc), "s"(lds_dst) : "memory"); }
#ifndef TPROBE_NDB
#define TPROBE_NDB 0
#endif
#define AT_WAITBAR(N) asm volatile("s_waitcnt vmcnt(" #N ") lgkmcnt(0)\n\ts_barrier" ::: "memory")
#ifdef TPROBE
#define TP_STAMP(x) do { AT_SB(); x = __builtin_amdgcn_s_memtime(); asm volatile("s_waitcnt lgkmcnt(0)" ::: "memory"); AT_SB(); } while (0)
#else
#define TP_STAMP(x) do {} while (0)
#endif
template <int NDB>
__device__ __forceinline__ void sweep(const bf16_t* Qp, const bf16_t* Kt, const bf16_t* Vt, float negMc, lds_ptr shm, f32x16 (&o)[NDB], float& l_out, unsigned long long (&tacc)[5]) {
    unsigned long long t0_ = 0, t1_ = 0, t2_ = 0, t3_ = 0, t4_ = 0;
    const int tid = threadIdx.x, lane = tid & 63, r32 = lane & 31, hi = lane >> 5; const int wid = __builtin_amdgcn_readfirstlane(tid >> 6);
    const unsigned lds0 = (unsigned)(uintptr_t)shm;
    const char* kgp = (const char*)Kt + wid * 1024 + lane * 16; const char* vgp = (const char*)Vt + wid * 1024 + lane * 16;
    const unsigned kdst = lds0 + L_K + wid * 1024, vdst = lds0 + L_V + wid * 1024;
#define AT_DMA(st) do { const int st_ = (st); if (st_ < 64) glds16(kgp + (size_t)(st_ + 1) * 8192, (unsigned)__builtin_amdgcn_readfirstlane(kdst + ((st_ + 1) % 3) * 8192)); \
        if (st_ <= 64) { _Pragma("unroll") for (int i_ = 0; i_ < NDB / 2; ++i_) glds16(vgp + (size_t)st_ * (NDB * 4096) + i_ * 8192, (unsigned)__builtin_amdgcn_readfirstlane(vdst + (st_ % 3) * 16384 + i_ * 8192)); } } while (0)
    glds16(kgp, (unsigned)__builtin_amdgcn_readfirstlane(kdst));
    AT_DMA(0);
    bf16x8 qr[4];
#pragma unroll
    for (int d0 = 0; d0 < 4; ++d0) qr[d0] = *(const bf16x8*)(Qp + (size_t)(wid * 32 + r32) * 64 + d0 * 16 + hi * 8);
#pragma unroll
    for (int db = 0; db < NDB; ++db)
#pragma unroll
        for (int r = 0; r < 16; ++r) o[db][r] = 0.f;
    float l = 0.f;
    const lds_cptr kp0 = (lds_cptr)shm + L_K + hi * 1024 + r32 * 16;
    const lds_cptr vp0 = (lds_cptr)shm + L_V + ((lane >> 4) & 1) * 32 + (lane & 3) * 8 + (4 * hi + ((lane & 15) >> 2)) * 64;
    f32x16 c0, c1; u32x4 pw[4]; bf16x8 kf[8], vf[8];
#ifndef GRP_MODE
#define GRP_MODE 0
#endif
#if GRP_MODE == 0
#define GRP_SEL(w) ((w) < 4)
#elif GRP_MODE == 1
#define GRP_SEL(w) (((w) & 1) == 0)
#else
#define GRP_SEL(w) (((w) & 2) == 0)
#endif
#define AT_BAR_P() do { AT_SB(); AT_WAITBAR(63); AT_SB(); } while (0)
#define AT_BAR_L(nxt) do { AT_SB(); if ((nxt) <= 63) { if (NDB == 2) AT_WAITBAR(2); else AT_WAITBAR(3); } else AT_WAITBAR(0); AT_SB(); } while (0)
#ifndef PRIO_MM
#define PRIO_MM 0
#endif
#ifndef PRIO_SPLIT
#define PRIO_SPLIT 0
#endif
#define AT_PHASE1(s) do { if (PRIO_MM && (PRIO_SPLIT == 0 || NDB == 4)) __builtin_amdgcn_s_setprio(PRIO_MM); const lds_cptr vp_ = vp0 + (((s) + 2) % 3) * 16384; \
        if ((s) == 0) phase1<NDB, false, true>(vp_, pw, o, qr, c0, c1, kf, vf); else if ((s) == 65) phase1<NDB, true, false>(vp_, pw, o, qr, c0, c1, kf, vf); \
        else phase1<NDB, true, true>(vp_, pw, o, qr, c0, c1, kf, vf); if (PRIO_MM && (PRIO_SPLIT == 0 || NDB == 4)) __builtin_amdgcn_s_setprio(0); } while (0)
#ifndef PRIO_SM
#define PRIO_SM 0
#endif
#define AT_FRAGS(s) do { const lds_cptr vq_ = vp0 + ((s) % 3) * 16384, kq_ = kp0 + (((s) + 1) % 3) * 8192; \
          _Pragma("unroll") for (int i_ = 0; i_ < (NDB == 2 ? NPRE2 : NPRE4); ++i_) vload1(vf[i_], vq_, i_); \
          if ((s) < 64) { _Pragma("unroll") for (int i_ = 0; i_ < 8; ++i_) kf[i_] = *(const __attribute__((address_space(3))) bf16x8*)(kq_ + (i_ >> 1) * 2048 + (i_ & 1) * 512); } } while (0)
#ifndef FRAGS_FIRST_B
#define FRAGS_FIRST_B 0
#endif
#define AT_PHASE2(s) do { if (NDB == 2 || FRAGS_FIRST_B) { AT_FRAGS(s); AT_SB(); } \
        if (PRIO_SM && (PRIO_SPLIT == 0 || NDB == 2)) __builtin_amdgcn_s_setprio(PRIO_SM); softmax_tile(c0, c1, l, pw); if (PRIO_SM && (PRIO_SPLIT == 0 || NDB == 2)) __builtin_amdgcn_s_setprio(0); \
        if (NDB != 2 && !FRAGS_FIRST_B) { AT_SB(); AT_FRAGS(s); } } while (0)
    if (NDB == 2) AT_WAITBAR(2); else AT_WAITBAR(3);
#pragma unroll
    for (int i_ = 0; i_ < 8; ++i_) kf[i_] = *(const __attribute__((address_space(3))) bf16x8*)(kp0 + (i_ >> 1) * 2048 + (i_ & 1) * 512);
    if (GRP_SEL(wid)) {
        for (int s = 0; s < 65; ++s) { TP_STAMP(t0_); AT_PHASE1(s); AT_DMA(s + 1); TP_STAMP(t1_); AT_BAR_L(s + 1); TP_STAMP(t2_); AT_PHASE2(s); TP_STAMP(t3_); AT_BAR_P(); TP_STAMP(t4_);
            if (NDB == TPROBE_NDB) { tacc[0] += t1_ - t0_; tacc[1] += t2_ - t1_; tacc[2] += t3_ - t2_; tacc[3] += t4_ - t3_; tacc[4] += 1; } }
        AT_PHASE1(65); AT_BAR_P(); AT_BAR_P();
    } else {
        AT_DMA(1); AT_BAR_L(1);
        for (int s = 0; s < 65; ++s) { TP_STAMP(t0_); AT_PHASE1(s); TP_STAMP(t1_); AT_BAR_P(); TP_STAMP(t2_); AT_PHASE2(s); AT_DMA(s + 2); TP_STAMP(t3_); AT_BAR_L(s + 2); TP_STAMP(t4_);
            if (NDB == TPROBE_NDB) { tacc[0] += t1_ - t0_; tacc[1] += t2_ - t1_; tacc[2] += t3_ - t2_; tacc[3] += t4_ - t3_; tacc[4] += 1; } }
        AT_PHASE1(65); AT_BAR_P();
    }
#undef AT_DMA
#undef AT_BAR_P
#undef AT_BAR_L
#undef AT_PHASE1
#undef AT_PHASE2
#undef AT_FRAGS
    l += __shfl_xor(l, 32);
    l_out = l;
}

__device__ __forceinline__ void inv_l_regs(float l, lds_ptr shm, int wid, int r32_, int hi_, float (&rli)[16]) {
    int r32 = r32_, hi = hi_; asm volatile("" : "+v"(r32), "+v"(hi));
    __attribute__((address_space(3))) float* wsf = (__attribute__((address_space(3))) float*)(shm + L_WS) + wid * 64;
    if (hi == 0) wsf[r32] = l;
    asm volatile("s_waitcnt lgkmcnt(0)" ::: "memory");
    const __attribute__((address_space(3))) float* rp = wsf + 4 * hi;
#pragma unroll
    for (int r = 0; r < 16; ++r) rli[r] = __builtin_amdgcn_rcpf(rp[(r & 3) + 8 * (r >> 2)]);
    asm volatile("s_waitcnt lgkmcnt(0)" ::: "memory");
}
template <int NDB>
__device__ __forceinline__ void store_rows(const f32x16 (&v)[NDB], lds_ptr shm, int wid, int lane_, bf16_t* dst) {
    int lane = lane_; asm volatile("" : "+v"(lane));
    const int r32 = lane & 31, hi = lane >> 5;
    __attribute__((address_space(3))) bf16_t* stg = (__attribute__((address_space(3))) bf16_t*)(shm + L_OST + wid * 8192);
    __attribute__((address_space(3))) bf16_t* wp = stg + (4 * hi) * (NDB * 32) + r32;
#pragma unroll
    for (int r = 0; r < 16; ++r)
#pragma unroll
        for (int db = 0; db < NDB; ++db) wp[((r & 3) + 8 * (r >> 2)) * (NDB * 32) + db * 32] = (bf16_t)f2bf(v[db][r]);
    asm volatile("s_waitcnt lgkmcnt(0)" ::: "memory");
    constexpr int CPR = NDB * 4;
    const int row0 = lane / CPR, ch = lane % CPR;
    const __attribute__((address_space(3))) bf16_t* rp = stg + row0 * (NDB * 32) + ch * 8; bf16_t* gp = dst + (size_t)row0 * 1024 + ch * 8;
#pragma unroll
    for (int i = 0; i < (32 * CPR) / 64; ++i) {
        const u32x4 w = *(const __attribute__((address_space(3))) u32x4*)(rp + i * (64 / CPR) * (NDB * 32));
        *(u32x4*)(gp + (size_t)i * (64 / CPR) * 1024) = w; }
    asm volatile("s_waitcnt lgkmcnt(0)" ::: "memory");
}

struct Tensors { const bf16_t *QA, *QB, *KA, *VA, *KB, *VB; bf16_t* MIX; float* stash; const float *gqa, *gka, *gqb, *gkb, *lq1, *lk1, *lq2, *lk2, *subg; };

__device__ __forceinline__ void phase(lds_ptr shm, const Tensors& T, int vcu, int G, int lo_item, int hi_item) {
    const int tid = threadIdx.x, lane = tid & 63, r32 = lane & 31, hi = lane >> 5; const int wid = __builtin_amdgcn_readfirstlane(tid >> 6);
    const float McA = 0.f, McB = 0.f;
    unsigned long long tacc[5] = {0, 0, 0, 0, 0};
#ifndef ATT_ONLY
#define ATT_ONLY 3
#endif
#ifndef STASH_LDS
#define STASH_LDS 0
#endif
#ifndef AB_SWAP
#define AB_SWAP 0
#endif
#define ATT_A_LOOP() do { \
    for (int item = lo_item + vcu; item < hi_item && item < 1024; item += G) { \
        if (item < 1024) { if (!(ATT_ONLY & 1)) continue; \
            const int b = (item >> 5) & 7, j = item & 31, i = item >> 8, kvh = i >> 1, idx = (i & 1) * 32 + j, h = kvh * 4 + (idx >> 4), qb = idx & 15; \
            f32x16 o[2]; float l; \
            sweep<2>(T.QA + ((size_t)(b * 8 + h) * 4096 + qb * 256) * 64, T.KA + (size_t)(b * 2 + kvh) * 65 * 4096, T.VA + (size_t)(b * 2 + kvh) * 65 * 4096, -McA, shm, o, l, tacc); \
            float rli[16]; inv_l_regs(l, shm, wid, r32, hi, rli); \
_Pragma("unroll") \
            for (int db = 0; db < 2; ++db) \
_Pragma("unroll") \
                for (int r = 0; r < 16; ++r) o[db][r] *= rli[r]; \
            store_rows<2>(o, shm, wid, lane, T.MIX + (size_t)(b * 4096 + qb * 256 + wid * 32) * 1024 + h * 64); \
        } } } while (0)
    const bool swapAB = AB_SWAP && ((blockIdx.x & 7) >= 4);
    if (!swapAB) ATT_A_LOOP();
    int item = lo_item + vcu; if (item < 1024) item += ((1024 - item + G - 1) / G) * G;
    const float lam = __expf(wave_sum(T.lq1[lane] * T.lk1[lane])) - __expf(wave_sum(T.lq2[lane] * T.lk2[lane])) + 0.2f;
    for (; item < hi_item; item += G) {
        { if (!(ATT_ONLY & 2)) continue;
            const int wb = item - 1024, b = (wb >> 5) & 7, j = wb & 31, i = wb >> 8, idx = i * 32 + j, hb = idx >> 4, qb = idx & 15;
            float* st = T.stash + ((size_t)(blockIdx.x * 8 + wid) * 64) * 64 + lane;
            asm volatile("" : "+v"(st));
            f32x16 o[4]; float l; float rli[16];
            sweep<4>(T.QB + ((size_t)(b * 8 + 2 * hb) * 4096 + qb * 256) * 64, T.KB + (size_t)(b * 8 + 2 * hb) * 65 * 4096, T.VB + (size_t)(b * 4 + hb) * 65 * 8192, -McB, shm, o, l, tacc);
            inv_l_regs(l, shm, wid, r32, hi, rli);
#if STASH_LDS
            { __attribute__((address_space(3))) u32x4* sl = (__attribute__((address_space(3))) u32x4*)(shm + L_OST + wid * 8192) + lane;
#pragma unroll
              for (int c = 0; c < 8; ++c) { const int db = c >> 1, r0 = (c & 1) * 8;
                  sl[c * 64] = (u32x4){cvtpk(o[db][r0] * rli[r0], o[db][r0 + 1] * rli[r0 + 1]), cvtpk(o[db][r0 + 2] * rli[r0 + 2], o[db][r0 + 3] * rli[r0 + 3]),
                                       cvtpk(o[db][r0 + 4] * rli[r0 + 4], o[db][r0 + 5] * rli[r0 + 5]), cvtpk(o[db][r0 + 6] * rli[r0 + 6], o[db][r0 + 7] * rli[r0 + 7])}; }
              asm volatile("s_waitcnt lgkmcnt(0)" ::: "memory"); }
#else
#pragma unroll
            for (int db = 0; db < 4; ++db)
#pragma unroll
                for (int r = 0; r < 16; ++r) st[(db * 16 + r) * 64] = o[db][r] * rli[r];
#endif
            sweep<4>(T.QB + ((size_t)(b * 8 + 2 * hb + 1) * 4096 + qb * 256) * 64, T.KB + (size_t)(b * 8 + 2 * hb + 1) * 65 * 4096, T.VB + (size_t)(b * 4 + hb) * 65 * 8192, -McB, shm, o, l, tacc);
            inv_l_regs(l, shm, wid, r32, hi, rli);
            asm volatile("" : "+v"(st));
            float ssq[16];
#pragma unroll
            for (int r = 0; r < 16; ++r) ssq[r] = 0.f;
#if STASH_LDS
            { const __attribute__((address_space(3))) u32x4* sl = (const __attribute__((address_space(3))) u32x4*)(shm + L_OST + wid * 8192) + lane;
              u32x4 sv[8];
#pragma unroll
              for (int c = 0; c < 8; ++c) sv[c] = sl[c * 64];
              asm volatile("s_waitcnt lgkmcnt(0)" ::: "memory");
#pragma unroll
              for (int c = 0; c < 8; ++c) { const int db = c >> 1, r0 = (c & 1) * 8;
#pragma unroll
                  for (int e = 0; e < 8; ++e) { const unsigned wd = sv[c][e >> 1]; const float o0 = __builtin_bit_cast(float, (e & 1) ? (wd & 0xffff0000u) : (wd << 16));
                      const float v = o0 - lam * (o[db][r0 + e] * rli[r0 + e]); o[db][r0 + e] = v; ssq[r0 + e] += v * v; } } }
#else
#pragma unroll
            for (int db = 0; db < 4; ++db)
#pragma unroll
                for (int r = 0; r < 16; ++r) { const float v = st[(db * 16 + r) * 64] - lam * (o[db][r] * rli[r]); o[db][r] = v; ssq[r] += v * v; }
#endif
#pragma unroll
            for (int r = 0; r < 16; ++r) { float s = ssq[r]; s += __shfl_xor(s, 1); s += __shfl_xor(s, 2); s += __shfl_xor(s, 4); s += __shfl_xor(s, 8); s += __shfl_xor(s, 16);
                ssq[r] = __builtin_amdgcn_rsqf(s * (1.f / 128.f) + 1e-6f) * 0.8f; }
#pragma unroll
            for (int db = 0; db < 4; ++db) { const float g = T.subg[db * 32 + r32];
#pragma unroll
                for (int r = 0; r < 16; ++r) o[db][r] *= ssq[r] * g; }
            store_rows<4>(o, shm, wid, lane, T.MIX + (size_t)(b * 4096 + qb * 256 + wid * 32) * 1024 + 512 + hb * 128);
        }
    }
    if (swapAB) ATT_A_LOOP();
#ifdef TPROBE
    if (blockIdx.x == 17 && wid == TPROBE_WAVE && tacc[4] > 0) {
        const unsigned long long ticks = tacc[TPROBE] / tacc[4] * 10ull;
        const unsigned long long r0 = __builtin_amdgcn_s_memrealtime(); while (__builtin_amdgcn_s_memrealtime() - r0 < ticks) __builtin_amdgcn_s_sleep(4);
    }
#endif
}
}
#define GAS __attribute__((address_space(1)))
#define LAS __attribute__((address_space(3)))
typedef unsigned v4u __attribute__((ext_vector_type(4)));
typedef float f32x4 __attribute__((ext_vector_type(4)));
typedef GAS unsigned gu32;
typedef GAS unsigned long long gu64;
#define RLX_AGENT __ATOMIC_RELAXED, __HIP_MEMORY_SCOPE_AGENT
#define LDS_WAIT() asm volatile("s_waitcnt lgkmcnt(0)" ::: "memory")
#define VM_WAIT() asm volatile("s_waitcnt vmcnt(0)" ::: "memory")
__device__ __forceinline__ unsigned pk2(float lo, float hi) { return f2bf(lo) | (f2bf(hi) << 16); }
#define XB_TMO      128
#define XB_XCNT(j)  (256  + 64 * (j))
#define XB_XSUB(j)  (1280 + 64 * (j))
#define XB_XGEN(j)  (2304 + 64 * (j))
#define XB_TOP      3328
#define XB_TOPGEN   3392
#define XCD_BAR_WORDS 3456
#define XB_SPIN_CAP (1u << 18)

__device__ __forceinline__ unsigned xb_ld(unsigned* p)              { return __hip_atomic_load(p, __ATOMIC_RELAXED, __HIP_MEMORY_SCOPE_AGENT); }
__device__ __forceinline__ unsigned xb_add(unsigned* p, unsigned v) { return __hip_atomic_fetch_add(p, v, __ATOMIC_RELAXED, __HIP_MEMORY_SCOPE_AGENT); }
__device__ __forceinline__ unsigned xb_xcc_id() { return (unsigned)__builtin_amdgcn_s_getreg((3 << 11) | 20) & 0xFu; }
#define XB_SPIN(cond, bar) do { unsigned _sp = 0; while (cond) { __builtin_amdgcn_s_sleep(1); \
    if ((++_sp & 255u) == 0u) { if (xb_ld(&(bar)[XB_TMO])) break; if (_sp > XB_SPIN_CAP) { atomicAdd(&(bar)[XB_TMO], 1u); break; } } } } while (0)

struct XcdBarrier {
    unsigned* bar; unsigned x;
    volatile LAS unsigned* st;
};

__device__ __forceinline__ XcdBarrier xcd_barrier_post(unsigned* bar, volatile LAS unsigned* st) {
    XcdBarrier b; b.bar = bar; b.x = xb_xcc_id(); b.st = st;
    if (threadIdx.x == 0) (void)xb_add(&bar[XB_XCNT(b.x)], 1u);
    return b;
}
__device__ __forceinline__ void xcd_barrier_complete(unsigned* bar, unsigned x, unsigned& nloc, unsigned& nx) {
    const unsigned G = gridDim.x * gridDim.y * gridDim.z;
    unsigned sum, cnt, mine, sp = 0u;
    for (;;) {
        sum = 0u; cnt = 0u; mine = 0u;
#pragma unroll
        for (unsigned j = 0; j < 16; ++j) { const unsigned c = xb_ld(&bar[XB_XCNT(j)]); sum += c; cnt += (c > 0u) ? 1u : 0u; mine = (j == x) ? c : mine; }
        if (sum == G) break;
        __builtin_amdgcn_s_sleep(1);
        if ((++sp & 255u) == 0u) { if (xb_ld(&bar[XB_TMO])) break; if (sp > XB_SPIN_CAP) { atomicAdd(&bar[XB_TMO], 1u); break; } }
    }
    nloc = mine > 0u ? mine : 1u; nx = cnt > 0u ? cnt : 1u;
}

__device__ __forceinline__ void xcd_barrier(const XcdBarrier& b) {
    asm volatile("s_waitcnt vmcnt(0)" ::: "memory");
    __syncthreads();
    if (threadIdx.x == 0) {
        unsigned* bar = b.bar;
        __builtin_amdgcn_s_waitcnt(0);
        unsigned nloc = b.st[0], nx = b.st[1];
        if (nloc == 0u) { xcd_barrier_complete(bar, b.x, nloc, nx); b.st[0] = nloc; b.st[1] = nx; }
        const unsigned old = xb_add(&bar[XB_XSUB(b.x)], 1u);
        const unsigned gen = old / nloc;
        if (old + 1u == (gen + 1u) * nloc) {
            __builtin_amdgcn_fence(__ATOMIC_RELEASE, "agent");
            asm volatile("s_waitcnt vmcnt(0)" ::: "memory");
            const unsigned og = xb_add(&bar[XB_TOP], 1u);
            const unsigned tg = og / nx;
            if (og + 1u == (tg + 1u) * nx) xb_add(&bar[XB_TOPGEN], 1u);
            else XB_SPIN(xb_ld(&bar[XB_TOPGEN]) == tg, bar);
            __builtin_amdgcn_fence(__ATOMIC_ACQUIRE, "agent");
            xb_add(&bar[XB_XGEN(b.x)], 1u);
            asm volatile("s_waitcnt vmcnt(0)" ::: "memory");
        } else {
            XB_SPIN(xb_ld(&bar[XB_XGEN(b.x)]) == gen, bar);
            __builtin_amdgcn_fence(__ATOMIC_ACQUIRE, "agent");
            asm volatile("s_waitcnt vmcnt(0)" ::: "memory");
        }
    }
    __syncthreads();
}
constexpr int NWAVES = 8;
#ifndef PG_SP2
#define PG_SP2 true
#endif
#ifndef P1_ALIGN
#define P1_ALIGN true
#endif
#ifndef P35_ALIGN
#define P35_ALIGN true
#endif
#ifndef P4_ALIGN
#define P4_ALIGN true
#endif
constexpr int RING_OFF = 0, RING_BYTES = 159744, LDSCTL_OFF = RING_BYTES, MISC_OFF = LDSCTL_OFF + 320, LDS_BYTES = 163840;
static_assert(att::L_END <= RING_BYTES, "attention LDS map");
constexpr int CW_BAR = 4096;
constexpr size_t CTL_ZERO_BYTES = 64 * 1024;
static_assert(WS_TA + 4097ull * 256 <= WS_TB && WS_TB + 4112ull * 256 <= WS_BT1 && WS_BT1 + 2304ull * 2048 <= WS_BT3 && WS_BT3 + 1024ull * 2048 <= WS_BT4 && WS_BT4 + 5632ull * 2048 <= WS_BT5 && WS_BT5 + 1024ull * 5632 <= WS_XB, "ws map 2");
static_assert(WS_STASH + 256ull * 8 * 64 * 64 * 4 <= WS_END, "stash");

struct Args { const float* in[18]; float* out; unsigned char* ws; RopeInv inv; int ph_lo, ph_hi; };
static_assert(sizeof(Args) == 18 * 8 + 8 + 8 + 192 + 8, "Args has no padding");

__device__ __forceinline__ float wave_sum_f(float v) {
#pragma unroll
    for (int o = 1; o < 64; o <<= 1) v += __shfl_xor(v, o);
    return v;
}
__device__ __forceinline__ void p0_transpose_item(const float* W, int K, int N, bf16_t* WT, int drow0, const float* gain, LAS float* scr, int kb, int n0, int lane) {
    const int k0 = 64 * kb;
#pragma unroll 16
    for (int i = 0; i < 32; ++i) { const int kk = 2 * i + (lane >> 5); scr[kk * 33 + (lane & 31)] = W[(size_t)(k0 + kk) * N + n0 + (lane & 31)] * (gain ? gain[k0 + kk] : 1.f); }
    LDS_WAIT(); asm volatile("" ::: "memory");
    const int c = lane & 7;
#pragma unroll
    for (int j = 0; j < 4; ++j) { const int n = (lane >> 3) + 8 * j; const LAS float* s = scr + (8 * c) * 33 + n;
        v4u o; o.x = pk2(s[0 * 33], s[1 * 33]); o.y = pk2(s[2 * 33], s[3 * 33]); o.z = pk2(s[4 * 33], s[5 * 33]); o.w = pk2(s[6 * 33], s[7 * 33]);
        *(GAS v4u*)(WT + (size_t)(drow0 + n) * K + k0 + 8 * c) = o; }
    LDS_WAIT(); asm volatile("" ::: "memory");
}

__device__ __forceinline__ void p0_prologue(const Args& A, LAS unsigned char* lds, int vcu, int G, int wave, int lane) {
    const float* x = A.in[0]; const float* meta = A.in[1]; const float* g1 = A.in[2]; const float* w_in = A.in[3]; const float* w_out = A.in[13]; const float* g2 = A.in[14];
    const float* w_gate = A.in[15]; const float* w_up = A.in[16]; const float* w_down = A.in[17];
    unsigned char* ws = A.ws;
    bf16_t *Bt1 = (bf16_t*)(ws + WS_BT1), *Bt3 = (bf16_t*)(ws + WS_BT3), *Bt4 = (bf16_t*)(ws + WS_BT4), *Bt5 = (bf16_t*)(ws + WS_BT5), *XB = (bf16_t*)(ws + WS_XB);
    float *ss = (float*)(ws + WS_RS), *ss2 = (float*)(ws + WS_SS), *TA = (float*)(ws + WS_TA), *TB = (float*)(ws + WS_TB);
    LAS float* scr = (LAS float*)(lds + RING_OFF + wave * 16384);
    const int gw = vcu * NWAVES + wave, NGW = G * NWAVES;
    constexpr int I_IN = 16 * 72;
    for (int it = gw; it < I_IN; it += NGW) { const int kb = it / 72, nb = it % 72, c0 = nb * 32; p0_transpose_item(w_in, 1024, 2304, Bt1, (c0 & ~255) + 128 * ((c0 & 63) >> 5) + 32 * ((c0 & 255) >> 6), g1, scr, kb, c0, lane); }
    for (int m0 = gw; m0 < 33024; m0 += 4 * NGW) {
        f32x4 v[4][4];
#pragma unroll
        for (int q = 0; q < 4; ++q) { const int m = m0 + q * NGW;
            if (m < NTOK + NMETA) { const GAS f32x4* xr = (const GAS f32x4*)(m < NTOK ? x + (size_t)m * 1024 : meta + (size_t)(m - NTOK) * 1024) + lane;
#pragma unroll
                for (int j = 0; j < 4; ++j) v[q][j] = xr[64 * j]; }
            else {
#pragma unroll
                for (int j = 0; j < 4; ++j) v[q][j] = (f32x4){0.f, 0.f, 0.f, 0.f}; } }
#pragma unroll
        for (int q = 0; q < 4; ++q) { const int m = m0 + q * NGW;
            if (m < 33024) {
                float s = 0.f;
#pragma unroll
                for (int j = 0; j < 4; ++j) s += (v[q][j].x * v[q][j].x + v[q][j].y * v[q][j].y) + (v[q][j].z * v[q][j].z + v[q][j].w * v[q][j].w);
                s = wave_sum_f(s);
                GAS unsigned long long* o8 = (GAS unsigned long long*)(XB + (size_t)m * 1024) + lane;
#pragma unroll
                for (int j = 0; j < 4; ++j) o8[64 * j] = (unsigned long long)pk2(v[q][j].x, v[q][j].y) | ((unsigned long long)pk2(v[q][j].z, v[q][j].w) << 32);
                if (lane == 0) ss[m] = m < NTOK + NMETA ? s : 1024.f;
            } }
    }
    const int gt = gw * 64 + lane, NGT = NGW * 64;
    for (int p = gt; p < 4097 + 4112; p += NGT) {
        const bool isA = p < 4097; const int pos = isA ? p : p - 4097; float* dst = (isA ? TA : TB) + (size_t)pos * 64;
        for (int i = 0; i < 32; ++i) {
            float ang;
            if (isA) ang = pos == 4096 ? 0.f : (i < 16 ? (float)(pos >> 6) * A.inv.a[i] : (float)(pos & 63) * A.inv.a[i - 16]);
            else ang = (float)pos * A.inv.b[i];
            float c, s; rope_cs(ang, c, s); dst[2 * i] = c; dst[2 * i + 1] = s;
        }
    }
    if (gw < 4) ((float*)(ws + WS_GT))[gw * 64 + lane] = A.in[4 + gw][lane];
    for (int i = gt; i < NTOK; i += NGT) ss2[i] = 0.f;
    {   bf16_t *KA = (bf16_t*)(ws + WS_KA), *VA = (bf16_t*)(ws + WS_VA), *KB = (bf16_t*)(ws + WS_KB), *VB = (bf16_t*)(ws + WS_VB);
        const v4u z = (v4u){0u, 0u, 0u, 0u};
        for (int i = gt; i < (16 + 64) * 384; i += NGT) { const int g = i / 384, e = i % 384, c = e / 48, k = 16 + e % 48;
            bf16_t* base = g < 16 ? KA + (size_t)g * 65 * 4096 : KB + (size_t)(g - 16) * 65 * 4096; *(GAS v4u*)(base + c * 512 + k * 8) = z; }
        for (int i = gt; i < 16 * 2 * 192 + 32 * 4 * 192; i += NGT) {
            if (i < 16 * 2 * 192) { const int g = i / 384, e = i % 384, db = e / 192, q = e % 192; *(GAS v4u*)(VA + (size_t)g * 65 * 4096 + db * 2048 + 16 * 32 + q * 8) = z; }
            else { const int i2 = i - 16 * 2 * 192, g = i2 / 768, e = i2 % 768, db = e / 192, q = e % 192; *(GAS v4u*)(VB + (size_t)g * 65 * 8192 + db * 2048 + 16 * 32 + q * 8) = z; }
        }
    }
}

__device__ __forceinline__ void p1_late_weights(const Args& A, LAS unsigned char* lds, int widx, int nw, int wave, int lane) {
    const float* w_out = A.in[13]; const float* g2 = A.in[14]; const float* w_gate = A.in[15]; const float* w_up = A.in[16]; const float* w_down = A.in[17];
    unsigned char* ws = A.ws;
    bf16_t *Bt3 = (bf16_t*)(ws + WS_BT3), *Bt4 = (bf16_t*)(ws + WS_BT4), *Bt5 = (bf16_t*)(ws + WS_BT5);
    LAS float* scr = (LAS float*)(lds + RING_OFF + wave * 16384);
    constexpr int I_OUT = 16 * 32, I_G = 16 * 88, I_D = 44 * 32, NITEMS = I_OUT + 2 * I_G + I_D;
    for (int it = widx; it < NITEMS; it += nw) {
        int r = it;
        if (r < I_OUT) { const int kb = r / 32, nb = r % 32; p0_transpose_item(w_out, 1024, 1024, Bt3, nb * 32, nullptr, scr, kb, nb * 32, lane); continue; } r -= I_OUT;
        if (r < I_G) { const int kb = r / 88, nb = r % 88, f0 = nb * 32; p0_transpose_item(w_gate, 1024, 2816, Bt4, 256 * (f0 >> 7) + (f0 & 127), g2, scr, kb, f0, lane); continue; } r -= I_G;
        if (r < I_G) { const int kb = r / 88, nb = r % 88, f0 = nb * 32; p0_transpose_item(w_up, 1024, 2816, Bt4, 256 * (f0 >> 7) + 128 + (f0 & 127), g2, scr, kb, f0, lane); continue; } r -= I_G;
        { const int kb = r / 32, nb = r % 32; p0_transpose_item(w_down, 2816, 1024, Bt5, nb * 32, nullptr, scr, kb, nb * 32, lane); }
    }
}

__global__ void __launch_bounds__(NWAVES * 64, 2) mega_fwd(Args args) {
    extern __shared__ __attribute__((aligned(16))) unsigned char lds_raw[];
    LAS unsigned char* lds = (LAS unsigned char*)lds_raw;
    volatile LAS unsigned* MISC = (volatile LAS unsigned*)(lds + MISC_OFF);
    const int tid = threadIdx.x, lane = tid & 63, wave = __builtin_amdgcn_readfirstlane(tid >> 6);
    const int G = gridDim.x; const int bx = blockIdx.x; const int vcu = (G % 8 == 0) ? (bx % 8) * (G / 8) + bx / 8 : bx;
    unsigned char* ws = args.ws;
    gu32* ctl = (gu32*)(ws + WS_CTL);
    for (int u = tid; u < (LDS_BYTES - LDSCTL_OFF) / 4; u += NWAVES * 64) ((LAS unsigned*)(lds + LDSCTL_OFF))[u] = 0u;
    __syncthreads();
    const int lo = args.ph_lo, hi = args.ph_hi;
    const bool multi = hi - lo > 1;
    XcdBarrier bar; bar.bar = (unsigned*)(ctl + CW_BAR); bar.x = 0; bar.st = nullptr;
    if (multi) bar = xcd_barrier_post((unsigned*)(ctl + CW_BAR), MISC + 8);
#ifndef STAG_N
#define STAG_N 8
#endif
#ifndef STAG_SEL
#define STAG_SEL ((bx >> 3) & (STAG_N - 1))
#endif
#ifndef PH_MASK
#define PH_MASK 63
#endif
#define IN(k) (((PH_MASK >> (k)) & 1) && lo <= (k) && (k) < hi)
#define SEAM(k) do { if (IN(k) && IN((k) + 1)) xcd_barrier(bar); } while (0)
    bf16_t *Bt1 = (bf16_t*)(ws + WS_BT1), *Bt3 = (bf16_t*)(ws + WS_BT3), *Bt4 = (bf16_t*)(ws + WS_BT4), *Bt5 = (bf16_t*)(ws + WS_BT5), *XB = (bf16_t*)(ws + WS_XB);
    bf16_t *QA = (bf16_t*)(ws + WS_QA), *QB = (bf16_t*)(ws + WS_QB), *KA = (bf16_t*)(ws + WS_KA), *VA = (bf16_t*)(ws + WS_VA), *KB = (bf16_t*)(ws + WS_KB), *VB = (bf16_t*)(ws + WS_VB);
    bf16_t *MIX = (bf16_t*)(ws + WS_MIX), *X1B = (bf16_t*)(ws + WS_X1B), *HID = (bf16_t*)(ws + WS_HID);
    float *ss = (float*)(ws + WS_RS), *ss2 = (float*)(ws + WS_SS), *TA = (float*)(ws + WS_TA), *TB = (float*)(ws + WS_TB);

    if (IN(0)) { p0_prologue(args, lds, vcu, G, wave, lane); SEAM(0); }
    if (IN(1)) {
        pg8::Gemm g{XB, Bt1, 33024, 2304, 1024}; pg8::StaticOrder S; S.init(33024, 2304, G, bx);
        pg8::EpiProj E{ss, (const float*)(ws + WS_GT), TA, (bf16_t*)ws};
#ifndef STAG1
#define STAG1 0
#endif
#ifndef STAG1B
#define STAG1B 0
#endif
#if STAG1 || STAG1B
        { const int rem_ = (129 * 9) % G; const unsigned long long r0_ = __builtin_amdgcn_s_memrealtime();
          const unsigned long long d_ = (rem_ != 0 && bx >= rem_) ? (unsigned long long)((bx - rem_) % 16) * STAG1 : (unsigned long long)((bx >> 3) & 7) * STAG1B;
          while (__builtin_amdgcn_s_memrealtime() - r0_ < d_) __builtin_amdgcn_s_sleep(1); }
#endif
        pg8::gemm_phase<pg8::EpiProj, pg8::StaticOrder, P1_ALIGN, PG_SP2>(lds + RING_OFF, g, S, E);
        { const int rem = (129 * 9) % G, first_idle = rem;
          if (bx >= first_idle) p1_late_weights(args, lds, (bx - first_idle) * NWAVES + wave, (G - first_idle) * NWAVES, wave, lane); }
        SEAM(1);
    }
    if (IN(2) || lo == 6 || lo == 7) {
        att::Tensors T{QA, QB, KA, VA, KB, VB, MIX, (float*)(ws + WS_STASH), args.in[4], args.in[5], args.in[6], args.in[7], args.in[8], args.in[9], args.in[10], args.in[11], args.in[12]};
#ifdef CLOCK_PROBE
        const unsigned long long t0_ = __builtin_amdgcn_s_memtime(), r0_ = __builtin_amdgcn_s_memrealtime();
#endif
        att::phase((att::lds_ptr)(lds + RING_OFF), T, vcu, G, lo == 7 ? 1024 : 0, hi == 7 && lo == 6 ? 1024 : 1536);
#ifdef CLOCK_PROBE
        { const unsigned long long t1_ = __builtin_amdgcn_s_memtime(), r1_ = __builtin_amdgcn_s_memrealtime();
          if (bx == 17 && tid == 0) { float* pr = (float*)(ws + WS_GT + 4096); pr[0] = (float)(t1_ - t0_) / (float)(r1_ - r0_) * 100.f; pr[1] = (float)(r1_ - r0_) * 0.01f; } }
#endif
        SEAM(2);
    }
    if (IN(3) || lo == 8) {
        pg8::Gemm g{MIX, Bt3, 32768, 1024, 1024}; pg8::StaticOrder S; S.init(32768, 1024, G, bx);
        pg8::EpiRes1 E{args.in[0], args.out, X1B, lo == 8 ? (float*)(ws + WS_STASH) : ss2, XB};
#ifndef STAG3
#define STAG3 0
#endif
#if STAG3
        { const unsigned long long r0_ = __builtin_amdgcn_s_memrealtime(); const unsigned long long d_ = (unsigned long long)(STAG_SEL) * STAG3;
          while (__builtin_amdgcn_s_memrealtime() - r0_ < d_) __builtin_amdgcn_s_sleep(1); }
#endif
        pg8::gemm_phase<pg8::EpiRes1, pg8::StaticOrder, P35_ALIGN, PG_SP2>(lds + RING_OFF, g, S, E);
        SEAM(3);
#ifdef XBAR_PROBE
        for (int i_ = 0; i_ < XBAR_PROBE; ++i_) xcd_barrier(bar);
#endif
    }
    if (IN(4)) {
        pg8::Gemm g{X1B, Bt4, 32768, 5632, 1024}; pg8::StaticOrder S; S.init(32768, 5632, G, bx);
        pg8::EpiSwiglu E{ss2, HID};
#ifndef STAG4
#define STAG4 0
#endif
#if STAG4
        { const unsigned long long r0_ = __builtin_amdgcn_s_memrealtime(); const unsigned long long d_ = (unsigned long long)(STAG_SEL) * STAG4;
          while (__builtin_amdgcn_s_memrealtime() - r0_ < d_) __builtin_amdgcn_s_sleep(1); }
#endif
        pg8::gemm_phase<pg8::EpiSwiglu, pg8::StaticOrder, P4_ALIGN, PG_SP2>(lds + RING_OFF, g, S, E);
        SEAM(4);
    }
    if (IN(5)) {
        pg8::Gemm g{HID, Bt5, 32768, 1024, 2816}; pg8::StaticOrder S; S.init(32768, 1024, G, bx);
        pg8::EpiRes2 E{args.out, X1B};
#ifndef STAG5
#define STAG5 0
#endif
#if STAG5
        { const unsigned long long r0_ = __builtin_amdgcn_s_memrealtime(); const unsigned long long d_ = (unsigned long long)(STAG_SEL) * STAG5;
          while (__builtin_amdgcn_s_memrealtime() - r0_ < d_) __builtin_amdgcn_s_sleep(1); }
#endif
        pg8::gemm_phase<pg8::EpiRes2, pg8::StaticOrder, P35_ALIGN, PG_SP2>(lds + RING_OFF, g, S, E);
    }
#undef IN
#undef SEAM
}
extern "C" void kernel_launch(void* const* d_in, const int* in_sizes, int n_in, void* d_out, int out_size, void* d_ws, size_t ws_size, hipStream_t stream) {
    float* out = (float*)d_out; unsigned char* ws = (unsigned char*)d_ws;
    if (n_in != 18 || ws_size < WS_END || out_size != NTOK * DM || in_sizes[0] != NTOK * DM) { fprintf(stderr, "kernel_launch: unexpected shapes (n_in %d, ws %zu, out %d)\n", n_in, ws_size, out_size); return; }
    RopeInv inv;
    for (int i = 0; i < 16; ++i) inv.a[i] = (float)pow(10000.0, -(double)(2 * i) / 32.0);
    for (int i = 0; i < 32; ++i) inv.b[i] = (float)pow(10000.0, -(double)(2 * i) / 64.0);
    static int grid = 0;
    if (grid == 0) {
        int dev = 0, cus = 0, per_cu = 0;
        if (hipGetDevice(&dev) != hipSuccess || hipDeviceGetAttribute(&cus, hipDeviceAttributeMultiprocessorCount, dev) != hipSuccess) { fprintf(stderr, "kernel_launch: device query failed\n"); grid = -1; return; }
        if (hipFuncSetAttribute((const void*)mega_fwd, hipFuncAttributeMaxDynamicSharedMemorySize, LDS_BYTES) != hipSuccess) { fprintf(stderr, "kernel_launch: hipFuncSetAttribute failed\n"); grid = -1; return; }
        if (hipOccupancyMaxActiveBlocksPerMultiprocessor(&per_cu, (const void*)mega_fwd, NWAVES * 64, LDS_BYTES) != hipSuccess || per_cu < 1) { fprintf(stderr, "kernel_launch: the occupancy query reports %d workgroups per CU for %d B of LDS; nothing launched\n", per_cu, LDS_BYTES); (void)hipGetLastError(); grid = -1; return; }
        (void)hipGetLastError();
        grid = cus;
    }
    if (grid < 0) return;
    Args a{};
    for (int i = 0; i < 18; ++i) a.in[i] = (const float*)d_in[i];
    a.out = out; a.ws = ws; a.inv = inv; a.ph_lo = 0; a.ph_hi = 6;
    (void)hipMemsetAsync(ws + WS_CTL, 0, CTL_ZERO_BYTES, stream);
    hipLaunchKernelGGL(mega_fwd, dim3(grid), dim3(NWAVES * 64), LDS_BYTES, stream, a);
}
```

```cpp
#define X1_BF16 1
#define XRES_BF16 1
#define NT_OUT 1
#define NT_HID 1
#include <hip/hip_runtime.h>
#include <cstdint>
#include <cstdio>
#include <cmath>

typedef unsigned short bf16_t;
namespace cfg {
constexpr int NB = 8, SEQ = 4096, NMETA = 16, DM = 1024, NTOK = NB * SEQ;
constexpr int INW = 2304, DFF = 2816, NT_KV = 65;
constexpr float EPS = 1e-6f, LOG2E = 1.4426950408889634f, C2 = 0.125f * LOG2E;
constexpr float LAM_INIT = 0.2f;
constexpr size_t MiB = 1u << 20;
constexpr size_t WS_CTL = 0, WS_RS = 1 * MiB, WS_SS = 1 * MiB + 256 * 1024;
constexpr size_t WS_GT = 1 * MiB + 448 * 1024;
constexpr size_t WS_TA = 2 * MiB, WS_TB = 4 * MiB, WS_BT1 = 6 * MiB, WS_BT3 = 11 * MiB, WS_BT4 = 13 * MiB, WS_BT5 = 24 * MiB;
constexpr size_t WS_XB = 32 * MiB;
constexpr size_t WS_QA = WS_XB + 33024ull * 2048;
constexpr size_t WS_QB = WS_QA + 32 * MiB;
constexpr size_t WS_KA = WS_QB + 32 * MiB;
constexpr size_t WS_VA = WS_KA + 16ull * NT_KV * 8192;
constexpr size_t WS_KB = WS_VA + 16ull * NT_KV * 8192;
constexpr size_t WS_VB = WS_KB + 64ull * NT_KV * 8192;
constexpr size_t WS_REND = WS_VB + 32ull * NT_KV * 16384;
constexpr size_t WS_HID = 32 * MiB;
constexpr size_t WS_MIX = 242 * MiB, WS_X1B = 306 * MiB, WS_STASH = 370 * MiB, WS_NAIVE = 306 * MiB, WS_PROJF = 242 * MiB, WS_END = 512 * MiB;
static_assert(WS_REND <= WS_MIX && WS_HID + 32768ull * DFF * 2 <= WS_MIX, "ws map");
}
using namespace cfg;

__host__ __device__ __forceinline__ unsigned f2bf(float f) { unsigned u = __builtin_bit_cast(unsigned, f); return (u + 0x7fffu + ((u >> 16) & 1u)) >> 16; }
__host__ __device__ __forceinline__ float bf2f(bf16_t h) { return __builtin_bit_cast(float, (unsigned)h << 16); }
__host__ __device__ __forceinline__ size_t kidx(int grp, int krow, int d) { return ((size_t)grp * NT_KV + (krow >> 6)) * 4096 + (d >> 3) * 512 + (krow & 63) * 8 + (d & 7); }
__host__ __device__ __forceinline__ size_t vidx(int grp, int krow, int d, int ndb) { return ((size_t)grp * NT_KV + (krow >> 6)) * (size_t)(ndb * 2048) + (d >> 5) * 2048 + (krow & 63) * 32 + (d & 31); }

struct RopeInv { float a[16]; float b[32]; };
__device__ __forceinline__ void rope_cs(float ang, float& c, float& s) {
    double rev = (double)ang * 0.15915494309189535; rev -= floor(rev); const float r = (float)rev;
    c = __builtin_amdgcn_cosf(r); s = __builtin_amdgcn_sinf(r);
}

#ifndef PG8_WGM
#define PG8_WGM 4
#endif
namespace pg8 {
#define PG8_LAS __attribute__((address_space(3)))
typedef unsigned short bf16_t;
typedef short bf16x8 __attribute__((ext_vector_type(8)));
typedef float f32x4 __attribute__((ext_vector_type(4)));
typedef unsigned u32x4 __attribute__((ext_vector_type(4)));
constexpr int BM = 256, BK = 64, HALF = 128, HTB = HALF * BK * 2  , STAGE_BYTES = 8 * HTB, NXCD = 8, WGM = PG8_WGM;

__host__ __device__ __forceinline__ int lds_byte(int r, int c) { const int st = (r >> 4) * 2 + (c >> 5), rr = r & 15, cc = c & 31, ob = rr * 64 + cc * 2; return st * 1024 + (ob ^ (((ob >> 9) & 1) << 5)); }
__host__ __device__ __forceinline__ void stage_rc(int b, int& R, int& C) { const int st = b / 1024, sb = b % 1024, swz = sb ^ (((sb >> 9) & 1) << 5); R = (st >> 1) * 16 + swz / 64; C = (st & 1) * 32 + (swz % 64) / 2; }
__host__ __device__ __forceinline__ int perm32(int rho) { const int n = rho >> 4, i = rho & 15; return 8 * (i >> 2) + 4 * n + (i & 3); }

struct Unit { int pm, pn; };
struct Gemm { const bf16_t* A; const bf16_t* Bt; int M, N, K; };

struct StaticOrder {
    int nM, nN, nwg, G, c, wgm;
    __host__ __device__ void init(int M, int N, int G_, int c_, int wgm_ = WGM) { nM = M / BM; nN = N / BM; nwg = nM * nN; G = G_; c = c_; wgm = wgm_; }
    __host__ __device__ bool next(int i, Unit& u) const {
        const long L = (long)i * G + c; if (L >= nwg) return false;
        int wgid = (int)L; { const int q = nwg / NXCD, r = nwg % NXCD, xcd = wgid % NXCD, off = wgid / NXCD; wgid = (xcd < r ? xcd * (q + 1) : r * (q + 1) + (xcd - r) * q) + off; }
        const int nig = wgm * nN, gid = wgid / nig, fm = gid * wgm, gsz = (nM - fm) < wgm ? (nM - fm) : wgm;
        u.pm = fm + ((wgid % nig) % gsz); u.pn = (wgid % nig) / gsz; return true;
    }
    __device__ __forceinline__ void a_ready(const Unit&) const {}
    __device__ __forceinline__ void done(const Unit&) const {}
};
struct P1Order : StaticOrder {
    int t5; bool remap;
    __host__ __device__ bool next(int i, Unit& u) const {
        if (!remap || i < 4) return StaticOrder::next(i, u);
        if (i > 4 || t5 >= 137) return false;
        StaticOrder s = *this; s.c = t5; return s.StaticOrder::next(4, u);
    }
};

__device__ __forceinline__ unsigned cvt_pk_bf16(float lo, float hi) { unsigned r; asm volatile("v_cvt_pk_bf16_f32 %0, %1, %2" : "=v"(r) : "v"(lo), "v"(hi)); return r; }

#ifndef RES_NTLOAD
#define RES_NTLOAD 0
#endif
#ifndef P5_A_NT
#define P5_A_NT 0
#endif
typedef unsigned u32x2 __attribute__((ext_vector_type(2)));
#ifndef RES2_SWAP
#define RES2_SWAP 0
#endif
#ifndef NT_QKV
#define NT_QKV 0
#endif
#ifndef NT_X1B
#define NT_X1B 0
#endif
#define PG8_ST16(p, v, NT) do { if (NT) __builtin_nontemporal_store((v), (u32x4*)(p)); else *(u32x4*)(p) = (v); } while (0)
#ifndef XSUM_SWAP
#define XSUM_SWAP 0
#endif
__device__ __forceinline__ float xsum16_32(float s) {
#if XSUM_SWAP
    float a = s, b = s;
    asm volatile("s_nop 1\n\tv_permlane16_swap_b32 %0, %1\n\ts_nop 1" : "+v"(a), "+v"(b));
    const float t = a + b; float c = t, d = t;
    asm volatile("s_nop 1\n\tv_permlane32_swap_b32 %0, %1\n\ts_nop 1" : "+v"(c), "+v"(d));
    return c + d;
#else
    s += __shfl_xor(s, 16); s += __shfl_xor(s, 32); return s;
#endif
}
struct EpiProj {
    static constexpr bool PERM = true, AFTER_DRAIN = false, A_NT = false;
    const float* ss; const float* GT; const float* TAB; bf16_t* wsb;
    static constexpr size_t TBOFF = (WS_TB - WS_TA) / 4, O_QA = WS_QA / 2, O_QB = WS_QB / 2, O_KA = WS_KA / 2, O_VA = WS_VA / 2, O_KB = WS_KB / 2, O_VB = WS_VB / 2;
    __device__ __forceinline__ void generic(const f32x4 (&acc)[2][2][4][2], const Unit& u, int wr, int wc, int fr_, int fq_) const {
        int fr = fr_, fq = fq_; asm volatile("" : "+v"(fr), "+v"(fq));
        const int slot = u.pn * 4 + wc; const bool metaT = (u.pm == 128);
        int type, hh;
        if (slot < 8) { type = 0; hh = slot; } else if (slot < 10) { type = 1; hh = slot - 8; } else if (slot < 12) { type = 2; hh = slot - 10; }
        else if (slot < 20) { type = 3; hh = slot - 12; } else if (slot < 28) { type = 4; hh = slot - 20; } else { type = 5; hh = slot - 28; }
        if (metaT && (type == 0 || type == 3)) return;
        const bool isB = type >= 3, normed = (type != 2 && type != 5), isQ = (type == 0 || type == 3);
        const int gi = type == 0 ? 0 : type == 1 ? 1 : type == 3 ? 2 : 3;
        f32x4 gv[2][2];
#pragma unroll
        for (int bj = 0; bj < 2; ++bj)
#pragma unroll
            for (int n = 0; n < 2; ++n) gv[bj][n] = *(const f32x4*)(GT + gi * 64 + 32 * bj + 8 * fq + 4 * n);
        const int b = u.pm >> 4, tbase = (u.pm & 15) * 256;
        size_t obase, bstride; int tilesz;
        if (type == 0)      { obase = O_QA + (size_t)hh * 4096 * 64; bstride = (size_t)8 * 4096 * 64; tilesz = 0; }
        else if (type == 3) { obase = O_QB + (size_t)hh * 4096 * 64; bstride = (size_t)8 * 4096 * 64; tilesz = 0; }
        else if (type == 1) { obase = O_KA + (size_t)hh * 65 * 4096; bstride = (size_t)2 * 65 * 4096; tilesz = 4096; }
        else if (type == 4) { obase = O_KB + (size_t)hh * 65 * 4096; bstride = (size_t)8 * 65 * 4096; tilesz = 4096; }
        else if (type == 2) { obase = O_VA + (size_t)hh * 65 * 4096; bstride = (size_t)2 * 65 * 4096; tilesz = 4096; }
        else                { obase = O_VB + (size_t)(hh >> 1) * 65 * 8192 + (size_t)((hh & 1) * 2) * 2048; bstride = (size_t)4 * 65 * 8192; tilesz = 8192; }
        const bool isK = (type == 1 || type == 4);
#pragma unroll
        for (int ai = 0; ai < 2; ++ai)
#pragma unroll
            for (int m = 0; m < 4; ++m) {
                if (metaT && (ai | m | wr)) continue;
                const int rloc = ai * 128 + wr * 64 + m * 16 + fr, row = u.pm * 256 + rloc, t = tbase + rloc;
                const float rsx = __builtin_amdgcn_rsqf(ss[row] * (1.f / 1024.f) + 1e-6f);
                f32x4 y[2][2]; float s = 0.f;
#pragma unroll
                for (int bj = 0; bj < 2; ++bj)
#pragma unroll
                    for (int n = 0; n < 2; ++n) { y[bj][n] = acc[ai][bj][m][n] * rsx; const f32x4 q = y[bj][n] * y[bj][n]; s += (q[0] + q[1]) + (q[2] + q[3]); }
                if (normed) {
                    s += __shfl_xor(s, 16); s += __shfl_xor(s, 32);
                    const float rn = __builtin_amdgcn_rsqf(s * (1.f / 64.f) + 1e-6f) * (isQ ? 0.18033688011112042f : 1.f);
                    const float* T = TAB + (isB ? TBOFF + (size_t)(metaT ? rloc : 16 + t) * 64 : (size_t)(metaT ? 4096 : t) * 64);
#pragma unroll
                    for (int bj = 0; bj < 2; ++bj)
#pragma unroll
                        for (int n = 0; n < 2; ++n) {
                            const f32x4 cs = *(const f32x4*)(T + (16 * bj + 4 * fq + 2 * n) * 2);
                            const f32x4 v = y[bj][n] * gv[bj][n] * rn;
                            y[bj][n] = (f32x4){v[0] * cs[0] - v[1] * cs[1], v[0] * cs[1] + v[1] * cs[0], v[2] * cs[2] - v[3] * cs[3], v[2] * cs[3] + v[3] * cs[2]};
                        }
                }
                u32x4 w[2];
#pragma unroll
                for (int bj = 0; bj < 2; ++bj) { w[bj].x = cvt_pk_bf16(y[bj][0][0], y[bj][0][1]); w[bj].y = cvt_pk_bf16(y[bj][0][2], y[bj][0][3]); w[bj].z = cvt_pk_bf16(y[bj][1][0], y[bj][1][1]); w[bj].w = cvt_pk_bf16(y[bj][1][2], y[bj][1][3]); }
                size_t off; int step;
                if (isQ) { off = (size_t)t * 64 + 8 * fq; step = 32; }
                else { const int krow = metaT ? rloc : 64 + t, tile = krow >> 6, key = krow & 63;
                    if (isK) { off = (size_t)tile * tilesz + fq * 512 + key * 8; step = 2048; } else { off = (size_t)tile * tilesz + key * 32 + 8 * fq; step = 2048; } }
                for (int bb = (metaT ? 0 : b); bb < (metaT ? 8 : b + 1); ++bb) { bf16_t* p = wsb + obase + (size_t)bb * bstride + off; PG8_ST16(p, w[0], NT_QKV); PG8_ST16(p + step, w[1], NT_QKV); }
                asm volatile("" ::: "memory");
            }
    }

    template <int TYPE>
    __device__ __forceinline__ void fast(const f32x4 (&acc)[2][2][4][2], const Unit& u, int wr, int fr_, int fq_, int hh) const {
        int fr = fr_, fq = fq_; asm volatile("" : "+v"(fr), "+v"(fq));
        constexpr bool isB = TYPE >= 3, normed = (TYPE != 2 && TYPE != 5), isQ = (TYPE == 0 || TYPE == 3), isK = (TYPE == 1 || TYPE == 4);
        constexpr int gi = TYPE == 0 ? 0 : TYPE == 1 ? 1 : TYPE == 3 ? 2 : 3;
        const int b = u.pm >> 4, tbase = (u.pm & 15) * 256;
        size_t obase; int tilesz;
        if (TYPE == 0)      { obase = O_QA + (size_t)(b * 8 + hh) * 4096 * 64; tilesz = 0; }
        else if (TYPE == 3) { obase = O_QB + (size_t)(b * 8 + hh) * 4096 * 64; tilesz = 0; }
        else if (TYPE == 1) { obase = O_KA + (size_t)(b * 2 + hh) * 65 * 4096; tilesz = 4096; }
        else if (TYPE == 4) { obase = O_KB + (size_t)(b * 8 + hh) * 65 * 4096; tilesz = 4096; }
        else if (TYPE == 2) { obase = O_VA + (size_t)(b * 2 + hh) * 65 * 4096; tilesz = 4096; }
        else                { obase = O_VB + (size_t)(b * 4 + (hh >> 1)) * 65 * 8192 + (size_t)((hh & 1) * 2) * 2048; tilesz = 8192; }
        bf16_t* dst = wsb + obase;
        f32x4 gv[2][2];
        if (normed) {
#pragma unroll
            for (int bj = 0; bj < 2; ++bj)
#pragma unroll
                for (int n = 0; n < 2; ++n) gv[bj][n] = *(const f32x4*)(GT + gi * 64 + 32 * bj + 8 * fq + 4 * n);
        }
        const int row0 = u.pm * 256 + wr * 64 + fr;
        float ssv[8];
#pragma unroll
        for (int it = 0; it < 8; ++it) ssv[it] = ss[row0 + (it >> 2) * 128 + (it & 3) * 16];
        const float* Tb = TAB + (isB ? TBOFF + (size_t)(16 + tbase + wr * 64 + fr) * 64 : (size_t)(tbase + wr * 64 + fr) * 64) + 8 * fq;
        f32x4 csb[2][2][2];
#define PROJ_CS(B, it) do { if (normed) { const float* T_ = Tb + (size_t)(((it) >> 2) * 128 + ((it) & 3) * 16) * 64; \
            _Pragma("unroll") for (int bj = 0; bj < 2; ++bj) _Pragma("unroll") for (int n = 0; n < 2; ++n) csb[B][bj][n] = *(const f32x4*)(T_ + 32 * bj + 4 * n); } } while (0)
        PROJ_CS(0, 0);
#pragma unroll
        for (int it = 0; it < 8; ++it) {
            const int ai = it >> 2, m = it & 3;
            if (it < 7) PROJ_CS((it + 1) & 1, it + 1);
            const int t = tbase + ai * 128 + wr * 64 + m * 16 + fr;
            const float rsx = __builtin_amdgcn_rsqf(ssv[it] * (1.f / 1024.f) + 1e-6f);
            f32x4 y[2][2]; float s = 0.f;
#pragma unroll
            for (int bj = 0; bj < 2; ++bj)
#pragma unroll
                for (int n = 0; n < 2; ++n) { y[bj][n] = acc[ai][bj][m][n] * rsx; const f32x4 q = y[bj][n] * y[bj][n]; s += (q[0] + q[1]) + (q[2] + q[3]); }
            if (normed) {
                s = xsum16_32(s);
                const float rn = __builtin_amdgcn_rsqf(s * (1.f / 64.f) + 1e-6f) * (isQ ? 0.18033688011112042f : 1.f);
#pragma unroll
                for (int bj = 0; bj < 2; ++bj)
#pragma unroll
                    for (int n = 0; n < 2; ++n) {
                        const f32x4 cs = csb[it & 1][bj][n];
                        const f32x4 v = y[bj][n] * gv[bj][n] * rn;
                        y[bj][n] = (f32x4){v[0] * cs[0] - v[1] * cs[1], v[0] * cs[1] + v[1] * cs[0], v[2] * cs[2] - v[3] * cs[3], v[2] * cs[3] + v[3] * cs[2]};
                    }
            }
            u32x4 w[2];
#pragma unroll
            for (int bj = 0; bj < 2; ++bj) { w[bj].x = cvt_pk_bf16(y[bj][0][0], y[bj][0][1]); w[bj].y = cvt_pk_bf16(y[bj][0][2], y[bj][0][3]); w[bj].z = cvt_pk_bf16(y[bj][1][0], y[bj][1][1]); w[bj].w = cvt_pk_bf16(y[bj][1][2], y[bj][1][3]); }
            size_t off; int step;
            if (isQ) { off = (size_t)t * 64 + 8 * fq; step = 32; }
            else { const int krow = 64 + t, tile = krow >> 6, key = krow & 63;
                if (isK) { off = (size_t)tile * tilesz + fq * 512 + key * 8; step = 2048; } else { off = (size_t)tile * tilesz + key * 32 + 8 * fq; step = 2048; } }
            PG8_ST16(dst + off, w[0], NT_QKV); PG8_ST16(dst + off + step, w[1], NT_QKV);
            asm volatile("" ::: "memory");
        }
#undef PROJ_CS
    }
    __device__ __forceinline__ void operator()(const f32x4 (&acc)[2][2][4][2], const Unit& u, int wr, int wc, int fr, int fq) const {
        if (u.pm == 128) { generic(acc, u, wr, wc, fr, fq); return; }
        const int slot = u.pn * 4 + wc;
        if (slot < 8) fast<0>(acc, u, wr, fr, fq, slot);
        else if (slot < 10) fast<1>(acc, u, wr, fr, fq, slot - 8);
        else if (slot < 12) fast<2>(acc, u, wr, fr, fq, slot - 10);
        else if (slot < 20) fast<3>(acc, u, wr, fr, fq, slot - 12);
        else if (slot < 28) fast<4>(acc, u, wr, fr, fq, slot - 20);
        else fast<5>(acc, u, wr, fr, fq, slot - 28);
    }
};

struct EpiRes1 {
    static constexpr bool PERM = true, AFTER_DRAIN = false, A_NT = false;
    const float* x; float* out; bf16_t* x1b; float* ss2; const bf16_t* xb;
    __device__ __forceinline__ void operator()(const f32x4 (&acc)[2][2][4][2], const Unit& u, int wr, int wc, int fr, int fq) const {
#pragma unroll
        for (int ai = 0; ai < 2; ++ai)
#pragma unroll
            for (int m = 0; m < 4; ++m) {
                const int row = u.pm * 256 + ai * 128 + wr * 64 + m * 16 + fr; float s = 0.f;
#pragma unroll
                for (int bj = 0; bj < 2; ++bj) {
                    const size_t off = (size_t)row * 1024 + u.pn * 256 + bj * 128 + wc * 32 + 8 * fq;
#ifdef XRES_BF16
                    const u32x4 xw = RES_NTLOAD ? __builtin_nontemporal_load((const u32x4*)(xb + off)) : *(const u32x4*)(xb + off);
                    const f32x4 x0 = {__builtin_bit_cast(float, xw.x << 16), __builtin_bit_cast(float, xw.x & 0xffff0000u), __builtin_bit_cast(float, xw.y << 16), __builtin_bit_cast(float, xw.y & 0xffff0000u)};
                    const f32x4 x1 = {__builtin_bit_cast(float, xw.z << 16), __builtin_bit_cast(float, xw.z & 0xffff0000u), __builtin_bit_cast(float, xw.w << 16), __builtin_bit_cast(float, xw.w & 0xffff0000u)};
                    const f32x4 a0 = x0 + acc[ai][bj][m][0], a1 = x1 + acc[ai][bj][m][1];
#else
                    const f32x4 a0 = *(const f32x4*)(x + off) + acc[ai][bj][m][0], a1 = *(const f32x4*)(x + off + 4) + acc[ai][bj][m][1];
#endif
#ifndef X1_BF16
                    *(f32x4*)(out + off) = a0; *(f32x4*)(out + off + 4) = a1;
#endif
                    u32x4 w; w.x = cvt_pk_bf16(a0[0], a0[1]); w.y = cvt_pk_bf16(a0[2], a0[3]); w.z = cvt_pk_bf16(a1[0], a1[1]); w.w = cvt_pk_bf16(a1[2], a1[3]);
                    PG8_ST16(x1b + off, w, NT_X1B);
                    const f32x4 q0 = a0 * a0, q1 = a1 * a1; s += ((q0[0] + q0[1]) + (q0[2] + q0[3])) + ((q1[0] + q1[1]) + (q1[2] + q1[3]));
                }
                s = xsum16_32(s);
                if (fq == 0) atomicAdd(ss2 + row, s);
            }
    }
};

struct EpiSwiglu {
    static constexpr bool PERM = true, AFTER_DRAIN = false, A_NT = false;
    const float* ss2; bf16_t* hid;
    __device__ __forceinline__ void operator()(const f32x4 (&acc)[2][2][4][2], const Unit& u, int wr, int wc, int fr, int fq) const {
        const int row0 = u.pm * 256 + wr * 64 + fr;
        float rs[8];
#pragma unroll
        for (int it = 0; it < 8; ++it) rs[it] = ss2[row0 + (it >> 2) * 128 + (it & 3) * 16];
#pragma unroll
        for (int it = 0; it < 8; ++it) rs[it] = __builtin_amdgcn_rsqf(rs[it] * (1.f / 1024.f) + 1e-6f);
#pragma unroll
        for (int ai = 0; ai < 2; ++ai)
#pragma unroll
            for (int m = 0; m < 4; ++m) {
                const int row = row0 + ai * 128 + m * 16;
                const float r = rs[ai * 4 + m];
                float h[8];
#pragma unroll
                for (int n = 0; n < 2; ++n)
#pragma unroll
                    for (int i = 0; i < 4; ++i) { const float g = acc[ai][0][m][n][i] * r, uu = acc[ai][1][m][n][i] * r;
                        h[n * 4 + i] = g * __builtin_amdgcn_rcpf(1.f + __builtin_amdgcn_exp2f(-1.4426950408889634f * g)) * uu; }
                u32x4 w; w.x = cvt_pk_bf16(h[0], h[1]); w.y = cvt_pk_bf16(h[2], h[3]); w.z = cvt_pk_bf16(h[4], h[5]); w.w = cvt_pk_bf16(h[6], h[7]);
#ifdef NT_HID
                __builtin_nontemporal_store(w, (u32x4*)(hid + (size_t)row * 2816 + u.pn * 128 + wc * 32 + 8 * fq));
#else
                *(u32x4*)(hid + (size_t)row * 2816 + u.pn * 128 + wc * 32 + 8 * fq) = w;
#endif
            }
    }
};

struct EpiRes2 {
    static constexpr bool PERM = true, AFTER_DRAIN = false, A_NT = (P5_A_NT != 0);
    float* out; const bf16_t* x1b;
    __device__ __forceinline__ void operator()(const f32x4 (&acc)[2][2][4][2], const Unit& u, int wr, int wc, int fr, int fq) const {
#pragma unroll
        for (int ai = 0; ai < 2; ++ai)
#pragma unroll
            for (int m = 0; m < 4; ++m) {
                const int row = u.pm * 256 + ai * 128 + wr * 64 + m * 16 + fr;
#pragma unroll
                for (int bj = 0; bj < 2; ++bj) {
                    const size_t off = (size_t)row * 1024 + u.pn * 256 + bj * 128 + wc * 32 + 8 * fq; float* p = out + off;
#ifdef X1_BF16
                    const u32x4 w = RES_NTLOAD ? __builtin_nontemporal_load((const u32x4*)(x1b + off)) : *(const u32x4*)(x1b + off);
                    const f32x4 r0 = {__builtin_bit_cast(float, w.x << 16), __builtin_bit_cast(float, w.x & 0xffff0000u), __builtin_bit_cast(float, w.y << 16), __builtin_bit_cast(float, w.y & 0xffff0000u)};
                    const f32x4 r1 = {__builtin_bit_cast(float, w.z << 16), __builtin_bit_cast(float, w.z & 0xffff0000u), __builtin_bit_cast(float, w.w << 16), __builtin_bit_cast(float, w.w & 0xffff0000u)};
#if RES2_SWAP
                    { f32x4 s0 = r0 + acc[ai][bj][m][0], s1 = r1 + acc[ai][bj][m][1];
#if RES2_SWAP == 2
#pragma unroll
                      for (int i = 0; i < 4; ++i) { const float p0 = __shfl_xor(s0[i], 16), p1 = __shfl_xor(s1[i], 16); if (fq & 1) s0[i] = p1; else s1[i] = p0; }
#else
                      { float a0 = s0[0], a1 = s0[1], a2 = s0[2], a3 = s0[3], b0 = s1[0], b1 = s1[1], b2 = s1[2], b3 = s1[3];
                        asm volatile("s_nop 1\n\tv_permlane16_swap_b32 %0, %4\n\tv_permlane16_swap_b32 %1, %5\n\tv_permlane16_swap_b32 %2, %6\n\tv_permlane16_swap_b32 %3, %7"
                                     : "+v"(a0), "+v"(a1), "+v"(a2), "+v"(a3), "+v"(b0), "+v"(b1), "+v"(b2), "+v"(b3));
                        s0 = (f32x4){a0, a1, a2, a3}; s1 = (f32x4){b0, b1, b2, b3}; }
#endif
                      float* pa = p + ((fq & 1) ? -4 : 0); float* pb = p + ((fq & 1) ? 4 : 8);
                      __builtin_nontemporal_store(s0, (f32x4*)pa); __builtin_nontemporal_store(s1, (f32x4*)pb); }
#else
#ifdef NT_OUT
                    __builtin_nontemporal_store(r0 + acc[ai][bj][m][0], (f32x4*)(p)); __builtin_nontemporal_store(r1 + acc[ai][bj][m][1], (f32x4*)(p + 4));
#else
                    *(f32x4*)(p) = r0 + acc[ai][bj][m][0]; *(f32x4*)(p + 4) = r1 + acc[ai][bj][m][1];
#endif
#endif
#else
                    *(f32x4*)(p) = *(const f32x4*)(p) + acc[ai][bj][m][0]; *(f32x4*)(p + 4) = *(const f32x4*)(p + 4) + acc[ai][bj][m][1];
#endif
                }
            }
    }
};
template <class Epi, class Sched, bool ALIGN_EPI = false, bool SP2 = false>
__device__ __forceinline__ void gemm_phase(PG8_LAS unsigned char* lds, const Gemm g, const Sched& S, const Epi& E, unsigned long long* epi_acc = nullptr) {
    const int tid = threadIdx.x, wid = __builtin_amdgcn_readfirstlane(tid >> 6), lane = tid & 63, wr = wid >> 2, wc = wid & 3, fr = lane & 15, fq = lane >> 4;
    const int K = g.K, nt = K / BK;
    unsigned voffA[2], voffB[2];
#pragma unroll
    for (int i = 0; i < 2; ++i) { int R, C; stage_rc(tid * 16 + i * 8192, R, C); const int Rb = Epi::PERM ? ((R & ~31) + perm32(R & 31)) : R;
        voffA[i] = (unsigned)(R * K + C) * 2u; voffB[i] = (unsigned)(Rb * K + C) * 2u; }
    const size_t kstep = (size_t)(BK * 2);
    const size_t hstep = (size_t)HALF * K * 2;
    const size_t tstep = 2 * hstep;
    const unsigned ldsw = (unsigned)wid * 1024u;
    const int aoff = lds_byte(wr * 64 + fr, fq * 8), boff = lds_byte(wc * 32 + fr, fq * 8);
#define PG8_SA(b, h) (((b) * 2 + (h)) * HTB)
#define PG8_SB(b, h) ((4 + (b) * 2 + (h)) * HTB)
#define PG8_STAGE_X(bufoff, gbase, voff, AUX) do { _Pragma("unroll") for (int _i = 0; _i < 2; ++_i) \
        __builtin_amdgcn_global_load_lds((const unsigned*)((const char*)(gbase) + (voff)[_i]), (PG8_LAS unsigned*)(lds + (bufoff) + ldsw + _i * 8192), 16, 0, AUX); } while (0)
#define PG8_STAGE(bufoff, gbase, voff) PG8_STAGE_X(bufoff, gbase, voff, 0)
#define PG8_STAGE_A(bufoff, gbase, voff) do { if constexpr (Epi::A_NT) PG8_STAGE_X(bufoff, gbase, voff, 2); else PG8_STAGE_X(bufoff, gbase, voff, 0); } while (0)
#define PG8_LDA(dst, b, h) do { _Pragma("unroll") for (int m = 0; m < 4; ++m) _Pragma("unroll") for (int k = 0; k < 2; ++k) dst[m][k] = *(const PG8_LAS bf16x8*)(lds + PG8_SA(b, h) + aoff + m * 2048 + k * 1024); } while (0)
#define PG8_LDB(dst, b, h) do { _Pragma("unroll") for (int n = 0; n < 2; ++n) _Pragma("unroll") for (int k = 0; k < 2; ++k) dst[n][k] = *(const PG8_LAS bf16x8*)(lds + PG8_SB(b, h) + boff + n * 2048 + k * 1024); } while (0)
#ifndef PG8_PRIO
#define PG8_PRIO 1
#endif
#ifndef PG8_PRIO_HALF
#define PG8_PRIO_HALF 1
#endif
#ifndef PG8_PRIO_HI
#define PG8_PRIO_HI 0
#endif
#define PG8_MMA(ai, bj, At, Bt) do { if (PG8_PRIO_HI) { if (wr == PG8_PRIO_HALF) __builtin_amdgcn_s_setprio(PG8_PRIO_HI); else __builtin_amdgcn_s_setprio(PG8_PRIO); } else if (PG8_PRIO) __builtin_amdgcn_s_setprio(PG8_PRIO); _Pragma("unroll") for (int m = 0; m < 4; ++m) _Pragma("unroll") for (int n = 0; n < 2; ++n) _Pragma("unroll") for (int k = 0; k < 2; ++k) \
        acc[ai][bj][m][n] = __builtin_amdgcn_mfma_f32_16x16x32_bf16(Bt[n][k], At[m][k], acc[ai][bj][m][n], 0, 0, 0); if (PG8_PRIO) __builtin_amdgcn_s_setprio(0); } while (0)
#define PG8_MMA_RAW(ai, bj, At, Bt) do {  _Pragma("unroll") for (int m = 0; m < 4; ++m) _Pragma("unroll") for (int n = 0; n < 2; ++n) _Pragma("unroll") for (int k = 0; k < 2; ++k) \
        acc[ai][bj][m][n] = __builtin_amdgcn_mfma_f32_16x16x32_bf16(Bt[n][k], At[m][k], acc[ai][bj][m][n], 0, 0, 0);  } while (0)
#define PG8_MMA2(a0, b0, A0, B0_, a1, b1, A1, B1_) do { if (PG8_MERGE_PRIO) { __builtin_amdgcn_s_setprio(PG8_PRIO); PG8_MMA_RAW(a0, b0, A0, B0_); PG8_MMA_RAW(a1, b1, A1, B1_); __builtin_amdgcn_s_setprio(0); } else { PG8_MMA(a0, b0, A0, B0_); PG8_MMA(a1, b1, A1, B1_); } } while (0)
#ifndef PG8_MERGE_PRIO
#define PG8_MERGE_PRIO 0
#endif
#define PG8_WAIT_V(n) asm volatile("s_waitcnt vmcnt(" #n ")" ::: "memory")
#define PG8_WAIT_L(n) asm volatile("s_waitcnt lgkmcnt(" #n ")" ::: "memory")
#define PG8_BAR __builtin_amdgcn_s_barrier()
#define PG8_SCHED __builtin_amdgcn_sched_barrier(0)
    Unit cur, nxt; int ui = 0;
    if (!S.next(0, cur)) return;
    f32x4 acc[2][2][4][2];
#pragma unroll
    for (int a = 0; a < 2; ++a)
#pragma unroll
        for (int b = 0; b < 2; ++b)
#pragma unroll
            for (int m = 0; m < 4; ++m)
#pragma unroll
                for (int n = 0; n < 2; ++n) acc[a][b][m][n] = (f32x4){0.f, 0.f, 0.f, 0.f};
    bf16x8 At[4][2], B0[2][2], B1[2][2];
    const char* cA = (const char*)g.A + (size_t)cur.pm * tstep; const char* cB = (const char*)g.Bt + (size_t)cur.pn * tstep;
    S.a_ready(cur);
    if constexpr (SP2) {
        PG8_STAGE(PG8_SB(0, 0), cB, voffB); PG8_STAGE(PG8_SB(0, 1), cB + hstep, voffB); PG8_STAGE_A(PG8_SA(0, 0), cA, voffA); PG8_STAGE_A(PG8_SA(0, 1), cA + hstep, voffA);
        if (wr == 1) PG8_BAR;
        PG8_WAIT_V(2); PG8_BAR;
        PG8_STAGE(PG8_SB(1, 0), cB + kstep, voffB); PG8_STAGE_A(PG8_SA(1, 0), cA + kstep, voffA); PG8_STAGE(PG8_SB(1, 1), cB + hstep + kstep, voffB);
        PG8_WAIT_V(6); PG8_BAR;
    } else {
        PG8_STAGE(PG8_SB(0, 0), cB, voffB); PG8_STAGE_A(PG8_SA(0, 0), cA, voffA); PG8_STAGE(PG8_SB(0, 1), cB + hstep, voffB); PG8_STAGE_A(PG8_SA(0, 1), cA + hstep, voffA);
        if (wr == 1) PG8_BAR;
        PG8_WAIT_V(4); PG8_BAR;
        PG8_STAGE(PG8_SB(1, 0), cB + kstep, voffB); PG8_STAGE_A(PG8_SA(1, 0), cA + kstep, voffA); PG8_STAGE(PG8_SB(1, 1), cB + hstep + kstep, voffB);
        PG8_WAIT_V(6); PG8_BAR;
    }
    for (;;) {
        const bool has_next = S.next(ui + 1, nxt);
        const char* nA = has_next ? (const char*)g.A + (size_t)nxt.pm * tstep : cA; const char* nB = has_next ? (const char*)g.Bt + (size_t)nxt.pn * tstep : cB;
        for (int t = 0; t < nt; t += 2) {
            const bool last = (t == nt - 2);
            const char* a1 = cA + (size_t)(t + 1) * kstep;
            const char* a2 = last ? nA : cA + (size_t)(t + 2) * kstep; const char* b2 = last ? nB : cB + (size_t)(t + 2) * kstep;
            const char* a3 = a2 + kstep; const char* b3 = b2 + kstep;
            if (last && has_next) S.a_ready(nxt);
            if constexpr (SP2) {
            PG8_LDB(B0, 0, 0); PG8_LDB(B1, 0, 1); PG8_SCHED; PG8_LDA(At, 0, 0); PG8_STAGE_A(PG8_SA(1, 1), a1 + hstep, voffA);
            PG8_WAIT_V(8); PG8_WAIT_L(0); PG8_BAR; PG8_MMA2(0, 0, At, B0, 0, 1, At, B1); PG8_BAR; PG8_SCHED;
            PG8_LDA(At, 0, 1); PG8_STAGE(PG8_SB(0, 0), b2, voffB); PG8_STAGE(PG8_SB(0, 1), b2 + hstep, voffB); PG8_STAGE_A(PG8_SA(0, 0), a2, voffA);
            PG8_WAIT_V(8); PG8_WAIT_L(0); PG8_BAR; PG8_MMA2(1, 0, At, B0, 1, 1, At, B1); PG8_BAR; PG8_SCHED;
            PG8_LDB(B0, 1, 0); PG8_LDB(B1, 1, 1); PG8_SCHED; PG8_LDA(At, 1, 0); PG8_STAGE_A(PG8_SA(0, 1), a2 + hstep, voffA);
            PG8_WAIT_V(8); PG8_WAIT_L(0); PG8_BAR; PG8_MMA2(0, 0, At, B0, 0, 1, At, B1); PG8_BAR; PG8_SCHED;
            PG8_LDA(At, 1, 1); PG8_STAGE(PG8_SB(1, 0), b3, voffB); PG8_STAGE(PG8_SB(1, 1), b3 + hstep, voffB); PG8_STAGE_A(PG8_SA(1, 0), a3, voffA);
            PG8_WAIT_V(8); PG8_WAIT_L(0); PG8_BAR; PG8_MMA2(1, 0, At, B0, 1, 1, At, B1); PG8_BAR; PG8_SCHED;
            } else {
            PG8_LDB(B0, 0, 0); PG8_SCHED; PG8_LDA(At, 0, 0); PG8_STAGE_A(PG8_SA(1, 1), a1 + hstep, voffA);
            PG8_WAIT_L(8); PG8_BAR; PG8_WAIT_L(0); PG8_MMA(0, 0, At, B0); PG8_BAR; PG8_SCHED;
            PG8_LDB(B1, 0, 1); PG8_STAGE(PG8_SB(0, 0), b2, voffB);
            PG8_BAR; PG8_WAIT_L(0); PG8_MMA(0, 1, At, B1); PG8_BAR;
            PG8_LDA(At, 0, 1); PG8_STAGE_A(PG8_SA(0, 0), a2, voffA);
            PG8_BAR; PG8_WAIT_L(0); PG8_MMA(1, 0, At, B0); PG8_BAR; PG8_SCHED;
            PG8_STAGE(PG8_SB(0, 1), b2 + hstep, voffB);
            PG8_WAIT_V(6); PG8_BAR; PG8_MMA(1, 1, At, B1); PG8_BAR;
            PG8_LDB(B0, 1, 0); PG8_SCHED; PG8_LDA(At, 1, 0); PG8_STAGE_A(PG8_SA(0, 1), a2 + hstep, voffA);
            PG8_WAIT_L(8); PG8_BAR; PG8_WAIT_L(0); PG8_MMA(0, 0, At, B0); PG8_BAR; PG8_SCHED;
            PG8_LDB(B1, 1, 1); PG8_STAGE(PG8_SB(1, 0), b3, voffB);
            PG8_BAR; PG8_WAIT_L(0); PG8_MMA(0, 1, At, B1); PG8_BAR;
            PG8_LDA(At, 1, 1); PG8_STAGE_A(PG8_SA(1, 0), a3, voffA);
            PG8_BAR; PG8_WAIT_L(0); PG8_MMA(1, 0, At, B0); PG8_BAR; PG8_SCHED;
            PG8_STAGE(PG8_SB(1, 1), b3 + hstep, voffB);
            PG8_WAIT_V(6); PG8_BAR; PG8_MMA(1, 1, At, B1); PG8_BAR;
            }
        }
        if constexpr (ALIGN_EPI) { if (wr == 0) PG8_BAR; }
#ifdef EPI_TIME_PROBE
        { const unsigned long long e0_ = __builtin_amdgcn_s_memrealtime(); E(acc, cur, wr, wc, fr, fq); asm volatile("s_waitcnt vmcnt(0)" ::: "memory"); if (epi_acc) *epi_acc += __builtin_amdgcn_s_memrealtime() - e0_; S.done(cur); }
#else
        if constexpr (!Epi::AFTER_DRAIN) { E(acc, cur, wr, wc, fr, fq); S.done(cur); }
#endif
        if (!has_next) break;
#pragma unroll
        for (int a = 0; a < 2; ++a)
#pragma unroll
            for (int b = 0; b < 2; ++b)
#pragma unroll
                for (int m = 0; m < 4; ++m)
#pragma unroll
                    for (int n = 0; n < 2; ++n) acc[a][b][m][n] = (f32x4){0.f, 0.f, 0.f, 0.f};
        cur = nxt; cA = nA; cB = nB; ++ui;
        if constexpr (ALIGN_EPI) { if (wr == 1) PG8_BAR; }
    }
    PG8_WAIT_V(0);
    if constexpr (!ALIGN_EPI) { if (wr == 0) PG8_BAR; }
    PG8_BAR;
    if constexpr (Epi::AFTER_DRAIN) { E.fused(acc, cur, wr, wc, fr, fq, lds, wid, lane); S.done(cur); }
#undef PG8_SA
#undef PG8_SB
#undef PG8_STAGE
#undef PG8_STAGE_X
#undef PG8_STAGE_A
#undef PG8_LDA
#undef PG8_LDB
#undef PG8_MMA
#undef PG8_MMA_RAW
#undef PG8_MMA2
#undef PG8_WAIT_V
#undef PG8_WAIT_L
#undef PG8_BAR
#undef PG8_SCHED
}
}
namespace att {
using bf16x8 = __attribute__((ext_vector_type(8))) short;
using s16x4 = __attribute__((ext_vector_type(4))) short;
using f32x16 = __attribute__((ext_vector_type(16))) float;
using u32x4 = __attribute__((ext_vector_type(4))) unsigned;
typedef short v4i16_t __attribute__((ext_vector_type(4)));
typedef __attribute__((address_space(3))) const char* lds_cptr;
typedef __attribute__((address_space(3))) char* lds_ptr;
constexpr int L_K = 0, L_V = 24576, L_WS = 73728, L_OST = 75776, L_END = L_OST + 8 * 8192;
__device__ __forceinline__ int crow(int r, int hi) { return (r & 3) + 8 * (r >> 2) + 4 * hi; }
__device__ __forceinline__ unsigned cvtpk(float lo, float hi) { unsigned r; asm volatile("v_cvt_pk_bf16_f32 %0, %1, %2" : "=v"(r) : "v"(lo), "v"(hi)); return r; }
__device__ __forceinline__ s16x4 vtr(lds_cptr p) { return __builtin_bit_cast(s16x4, __builtin_amdgcn_ds_read_tr16_b64_v4i16((__attribute__((address_space(3))) v4i16_t*)p)); }
__device__ __forceinline__ float fadd_s(float a, float b) { float r; asm("v_add_f32_e32 %0, %1, %2" : "=v"(r) : "v"(a), "v"(b)); return r; }
__device__ __forceinline__ float wave_max(float v) { for (int o = 1; o < 64; o <<= 1) v = fmaxf(v, __shfl_xor(v, o)); return v; }
__device__ __forceinline__ float wave_sum(float v) { for (int o = 1; o < 64; o <<= 1) v += __shfl_xor(v, o); return v; }

#define AT_SB() __builtin_amdgcn_sched_barrier(0)
__device__ __forceinline__ void vload4(bf16x8 (&vf)[4], lds_cptr vp) {
#pragma unroll
    for (int ks = 0; ks < 4; ++ks) { const s16x4 lo = vtr(vp + ks * 1024), hi4 = vtr(vp + ks * 1024 + 512); vf[ks] = (bf16x8){lo[0], lo[1], lo[2], lo[3], hi4[0], hi4[1], hi4[2], hi4[3]}; }
}
#ifndef ONES_A
#define ONES_A 0
#endif
#ifndef PV_INTERLEAVE
#define PV_INTERLEAVE 0
#endif
#define PV_J(i) (PV_INTERLEAVE ? (((i) % NDB) * 4 + (i) / NDB) : (i))
#ifndef RING_DEPTH
#define RING_DEPTH 4
#endif
#ifndef NPRE2
#define NPRE2 0
#endif
#ifndef NPRE4
#define NPRE4 0
#endif
__device__ __forceinline__ void vload1(bf16x8& vf, lds_cptr vp, int i) { const s16x4 lo = vtr(vp + (i >> 2) * 4096 + (i & 3) * 1024), hi4 = vtr(vp + (i >> 2) * 4096 + (i & 3) * 1024 + 512); vf = (bf16x8){lo[0], lo[1], lo[2], lo[3], hi4[0], hi4[1], hi4[2], hi4[3]}; }
template <int NDB, bool HASPV, bool HASQK>
__device__ __forceinline__ void phase1(lds_cptr vp, const u32x4 (&pw)[4], f32x16 (&o)[NDB], const bf16x8 (&qr)[4], f32x16& c0, f32x16& c1, const bf16x8 (&kf)[8], const bf16x8 (&vf)[8], f32x16& ol) {
    constexpr int NPRE = (NDB == 2) ? NPRE2 : NPRE4;
    constexpr int RD = RING_DEPTH;
    bf16x8 vr[RD];
    if (HASPV && NPRE < 4 * NDB) {
#pragma unroll
        for (int i = 0; i < RD; ++i) vload1(vr[i], vp, PV_J(NPRE + i));
        AT_SB();
    }
    if (HASQK) {
        const f32x16 z = {0.f, 0.f, 0.f, 0.f, 0.f, 0.f, 0.f, 0.f, 0.f, 0.f, 0.f, 0.f, 0.f, 0.f, 0.f, 0.f};
        f32x16 n0 = z, n1 = z;
        if (!HASPV) {
#pragma unroll
            for (int r = 0; r < 16; ++r) { n0[r] = (r < 8) ? 0.f : -30000.f; n1[r] = -30000.f; }
        }
#pragma unroll
        for (int d0 = 0; d0 < 4; ++d0) {
            c0 = __builtin_amdgcn_mfma_f32_32x32x16_bf16(kf[2 * d0], qr[d0], d0 == 0 ? n0 : c0, 0, 0, 0);
            c1 = __builtin_amdgcn_mfma_f32_32x32x16_bf16(kf[2 * d0 + 1], qr[d0], d0 == 0 ? n1 : c1, 0, 0, 0);
        }
        AT_SB();
    }
    if (HASPV && NDB == 2 && ONES_A) {
        const bf16x8 ones = {0x3F80, 0x3F80, 0x3F80, 0x3F80, 0x3F80, 0x3F80, 0x3F80, 0x3F80};
#pragma unroll
        for (int ks = 0; ks < 4; ++ks) ol = __builtin_amdgcn_mfma_f32_32x32x16_bf16(__builtin_bit_cast(bf16x8, pw[ks]), ones, ol, 0, 0, 0);
    }
    if (HASPV) {
#pragma unroll
        for (int i = 0; i < 4 * NDB; ++i) {
            if (i < NPRE) o[i >> 2] = __builtin_amdgcn_mfma_f32_32x32x16_bf16(__builtin_bit_cast(bf16x8, pw[i & 3]), vf[i & 7], o[i >> 2], 0, 0, 0);
            else { const int j_ = PV_J(i); o[j_ >> 2] = __builtin_amdgcn_mfma_f32_32x32x16_bf16(__builtin_bit_cast(bf16x8, pw[j_ & 3]), vr[(i - NPRE) % RD], o[j_ >> 2], 0, 0, 0);
                   if (i + RD < 4 * NDB) vload1(vr[(i - NPRE) % RD], vp, PV_J(i + RD)); AT_SB(); }
        }
    }
}
#ifndef EXP_THEN_ADD
#define EXP_THEN_ADD 0
#endif
#ifndef SUM_DOT2
#define SUM_DOT2 0
#endif
#ifndef SUM_PK2
#define SUM_PK2 0
#endif
template <bool SUM>
__device__ __forceinline__ void softmax_tile(f32x16& c0, f32x16& c1, float& l, u32x4 (&pw)[4]) {
#ifdef SUM_PK
    { float sa = 0.f, sb = 0.f;
#pragma unroll
      for (int r = 0; r < 16; ++r) { c0[r] = __builtin_amdgcn_exp2f(c0[r]); c1[r] = __builtin_amdgcn_exp2f(c1[r]); sa += c0[r]; sb += c1[r]; }
      l += sa + sb; }
#elif SUM_PK2
    { typedef float f32x2_ __attribute__((ext_vector_type(2)));
      f32x2_ s0 = {0.f, 0.f}, s1 = {0.f, 0.f};
#pragma unroll
      for (int r = 0; r < 16; r += 2) { c0[r] = __builtin_amdgcn_exp2f(c0[r]); c0[r + 1] = __builtin_amdgcn_exp2f(c0[r + 1]); c1[r] = __builtin_amdgcn_exp2f(c1[r]); c1[r + 1] = __builtin_amdgcn_exp2f(c1[r + 1]);
          s0 += (f32x2_){c0[r], c0[r + 1]}; s1 += (f32x2_){c1[r], c1[r + 1]}; }
      s0 += s1; l += s0.x + s0.y; }
#elif SUM_DOT2
#pragma unroll
    for (int r = 0; r < 16; ++r) { c0[r] = __builtin_amdgcn_exp2f(c0[r]); c1[r] = __builtin_amdgcn_exp2f(c1[r]); }
    AT_SB(); asm volatile("s_nop 1" ::: "memory"); AT_SB();
#else
#pragma unroll
    for (int r = 0; r < 16; ++r) { c0[r] = __builtin_amdgcn_exp2f(c0[r]); c1[r] = __builtin_amdgcn_exp2f(c1[r]); if (SUM && !EXP_THEN_ADD) { l += c0[r]; l += c1[r]; } }
    if (SUM && EXP_THEN_ADD) {
#pragma unroll
        for (int r = 0; r < 16; ++r) { l += c0[r]; l += c1[r]; } }
#endif
#ifdef PROBE_DUP_VALU
    { float dz = 0.f;
#pragma unroll
      for (int r = 0; r < 16; ++r) { dz += __builtin_amdgcn_exp2f(c0[r]); dz += __builtin_amdgcn_exp2f(c1[r]); }
      asm volatile("" :: "v"(dz)); }
#endif
#pragma unroll
    for (int k = 0; k < 2; ++k) {
        pw[k] = (u32x4){cvtpk(c0[8 * k + 0], c0[8 * k + 1]), cvtpk(c0[8 * k + 2], c0[8 * k + 3]), cvtpk(c0[8 * k + 4], c0[8 * k + 5]), cvtpk(c0[8 * k + 6], c0[8 * k + 7])};
        pw[2 + k] = (u32x4){cvtpk(c1[8 * k + 0], c1[8 * k + 1]), cvtpk(c1[8 * k + 2], c1[8 * k + 3]), cvtpk(c1[8 * k + 4], c1[8 * k + 5]), cvtpk(c1[8 * k + 6], c1[8 * k + 7])};
    }
#if SUM_DOT2
    { float la = 0.f, lb = 0.f; const unsigned ones = 0x3f803f80u;
#pragma unroll
      for (int k = 0; k < 4; ++k) {
          asm volatile("v_dot2c_f32_bf16 %0, %1, %2" : "+v"(la) : "v"(pw[k].x), "v"(ones)); asm volatile("v_dot2c_f32_bf16 %0, %1, %2" : "+v"(lb) : "v"(pw[k].y), "v"(ones));
          asm volatile("v_dot2c_f32_bf16 %0, %1, %2" : "+v"(la) : "v"(pw[k].z), "v"(ones)); asm volatile("v_dot2c_f32_bf16 %0, %1, %2" : "+v"(lb) : "v"(pw[k].w), "v"(ones)); }
      l += la + lb; }
#endif
}
__device__ __forceinline__ void glds16(const void* gsrc, unsigned lds_dst) { unsigned keep;
    asm volatile("s_mov_b32 %0, m0\n\ts_mov_b32 m0, %2\n\ts_nop 0\n\tglobal_load_lds_dwordx4 %1, off\n\ts_mov_b32 m0, %0" : "=&s"(keep) : "v"(gsrc), "s"(lds_dst) : "memory"); }
#ifndef TPROBE_NDB
#define TPROBE_NDB 0
#endif
#define AT_WAITBAR(N) asm volatile("s_waitcnt vmcnt(" #N ") lgkmcnt(0)\n\ts_barrier" ::: "memory")
#ifdef TPROBE
#define TP_STAMP(x) do { AT_SB(); x = __builtin_amdgcn_s_memtime(); asm volatile("s_waitcnt lgkmcnt(0)" ::: "memory"); AT_SB(); } while (0)
#else
#define TP_STAMP(x) do {} while (0)
#endif
#ifndef EARLY_Q
#define EARLY_Q 0
#endif
#ifndef Q_PRE
#define Q_PRE 1
#endif
__device__ __forceinline__ void load_q(const bf16_t* Qp, int wid, int r32, int hi, bf16x8 (&q)[4]) {
#pragma unroll
    for (int d0 = 0; d0 < 4; ++d0) q[d0] = *(const bf16x8*)(Qp + (size_t)(wid * 32 + r32) * 64 + d0 * 16 + hi * 8);
}
template <int NDB>
__device__ __forceinline__ void sweep_prefetch(const bf16_t* Kt, const bf16_t* Vt, lds_ptr shm) {
    const int tid = threadIdx.x, lane = tid & 63; const int wid = __builtin_amdgcn_readfirstlane(tid >> 6);
    const unsigned lds0 = (unsigned)(uintptr_t)shm;
    const char* kgp = (const char*)Kt + wid * 1024 + lane * 16; const char* vgp = (const char*)Vt + wid * 1024 + lane * 16;
    const unsigned kdst = lds0 + L_K + wid * 1024, vdst = lds0 + L_V + wid * 1024;
    glds16(kgp, (unsigned)__builtin_amdgcn_readfirstlane(kdst));
    glds16(kgp + 8192, (unsigned)__builtin_amdgcn_readfirstlane(kdst + 8192));
#pragma unroll
    for (int i_ = 0; i_ < NDB / 2; ++i_) glds16(vgp + i_ * 8192, (unsigned)__builtin_amdgcn_readfirstlane(vdst + i_ * 8192));
}
template <int NDB>
__device__ __forceinline__ void sweep(const bf16_t* Qp, const bf16_t* Kt, const bf16_t* Vt, float negMc, lds_ptr shm, f32x16 (&o)[NDB], float& l_out, unsigned long long (&tacc)[5], f32x16& ol, bool pre, bf16x8 (&qn)[4], const bf16_t* Qnx = nullptr, bool haveq = false) {
#ifdef ATT_EPI_PROBE
    const unsigned long long pro0_ = __builtin_amdgcn_s_memrealtime();
#endif
    unsigned long long t0_ = 0, t1_ = 0, t2_ = 0, t3_ = 0, t4_ = 0;
    const int tid = threadIdx.x, lane = tid & 63, r32 = lane & 31, hi = lane >> 5; const int wid = __builtin_amdgcn_readfirstlane(tid >> 6);
    const unsigned lds0 = (unsigned)(uintptr_t)shm;
    const char* kgp = (const char*)Kt + wid * 1024 + lane * 16; const char* vgp = (const char*)Vt + wid * 1024 + lane * 16;
    const unsigned kdst = lds0 + L_K + wid * 1024, vdst = lds0 + L_V + wid * 1024;
#define AT_DMA(st) do { const int st_ = (st); if (st_ < 64) glds16(kgp + (size_t)(st_ + 1) * 8192, (unsigned)__builtin_amdgcn_readfirstlane(kdst + ((st_ + 1) % 3) * 8192)); \
        if (st_ <= 64) { _Pragma("unroll") for (int i_ = 0; i_ < NDB / 2; ++i_) glds16(vgp + (size_t)st_ * (NDB * 4096) + i_ * 8192, (unsigned)__builtin_amdgcn_readfirstlane(vdst + (st_ % 3) * 16384 + i_ * 8192)); } } while (0)
    if (!pre) { glds16(kgp, (unsigned)__builtin_amdgcn_readfirstlane(kdst));
        AT_DMA(0); }
#ifndef GRP_MODE
#define GRP_MODE 0
#endif
#define GRP_MODE_IS0 (GRP_MODE == 0)
#ifndef DMA_SPLIT_A
#define DMA_SPLIT_A 1
#endif
#ifndef DMA_SPLIT_B
#define DMA_SPLIT_B 0
#endif
    constexpr bool SPLIT = (NDB == 2) ? (DMA_SPLIT_A != 0) : (DMA_SPLIT_B != 0);
    static_assert(!SPLIT || GRP_MODE_IS0, "role-split staging assumes X role = waves 0-3");
    constexpr int SPW = NDB;
    const bool xrole_ = wid < 4; const int wl_ = wid & 3;
    const char* sgp = (xrole_ ? (const char*)Kt + wl_ * 2048 : (const char*)Vt + wl_ * (SPW * 1024)) + lane * 16;
    const unsigned sdst = lds0 + (xrole_ ? L_K + wl_ * 2048 : L_V + wl_ * (SPW * 1024));
#define AT_DMAS_K(st) do { const int st_ = (st); if (st_ < 64) { _Pragma("unroll") for (int p_ = 0; p_ < 2; ++p_) glds16(sgp + (size_t)(st_ + 1) * 8192 + p_ * 1024, (unsigned)__builtin_amdgcn_readfirstlane(sdst + ((st_ + 1) % 3) * 8192 + p_ * 1024)); } } while (0)
#define AT_DMAS_V(t) do { const int t_ = (t); if (t_ <= 64) { _Pragma("unroll") for (int p_ = 0; p_ < SPW; ++p_) glds16(sgp + (size_t)t_ * (NDB * 4096) + p_ * 1024, (unsigned)__builtin_amdgcn_readfirstlane(sdst + (t_ % 3) * 16384 + p_ * 1024)); } } while (0)
    bf16x8 qr[4];
#pragma unroll
    for (int d0 = 0; d0 < 4; ++d0) { if (Q_PRE) qr[d0] = qn[d0]; else qr[d0] = *(const bf16x8*)(Qp + (size_t)(wid * 32 + r32) * 64 + d0 * 16 + hi * 8); }
#pragma unroll
    for (int db = 0; db < NDB; ++db)
#pragma unroll
        for (int r = 0; r < 16; ++r) o[db][r] = 0.f;
    float l = 0.f;
#pragma unroll
    for (int r = 0; r < 16; ++r) ol[r] = 0.f;
    const lds_cptr kp0 = (lds_cptr)shm + L_K + hi * 1024 + r32 * 16;
    const lds_cptr vp0 = (lds_cptr)shm + L_V + ((lane >> 4) & 1) * 32 + (lane & 3) * 8 + (4 * hi + ((lane & 15) >> 2)) * 64;
    f32x16 c0, c1; u32x4 pw[4]; bf16x8 kf[8], vf[8];
#ifndef GRP_MODE
#define GRP_MODE 0
#endif
#if GRP_MODE == 0
#define GRP_SEL(w) ((w) < 4)
#elif GRP_MODE == 1
#define GRP_SEL(w) (((w) & 1) == 0)
#else
#define GRP_SEL(w) (((w) & 2) == 0)
#endif
#define AT_BAR_P() do { AT_SB(); AT_WAITBAR(63); AT_SB(); } while (0)
#define AT_BAR_L(nxt) do { AT_SB(); if ((nxt) <= 63) { if (NDB == 2) AT_WAITBAR(2); else AT_WAITBAR(3); } else AT_WAITBAR(0); AT_SB(); } while (0)
#ifndef PRIO_MM
#define PRIO_MM 0
#endif
#ifndef PRIO_SPLIT
#define PRIO_SPLIT 0
#endif
#define AT_PHASE1(s) do { if (PRIO_MM && (PRIO_SPLIT == 0 || NDB == 4)) __builtin_amdgcn_s_setprio(PRIO_MM); const lds_cptr vp_ = vp0 + (((s) + 2) % 3) * 16384; \
        if ((s) == 0) phase1<NDB, false, true>(vp_, pw, o, qr, c0, c1, kf, vf, ol); else if ((s) == 65) phase1<NDB, true, false>(vp_, pw, o, qr, c0, c1, kf, vf, ol); \
        else phase1<NDB, true, true>(vp_, pw, o, qr, c0, c1, kf, vf, ol); if (PRIO_MM && (PRIO_SPLIT == 0 || NDB == 4)) __builtin_amdgcn_s_setprio(0); } while (0)
#ifndef PRIO_SM
#define PRIO_SM 0
#endif
#define AT_FRAGS(s) do { const lds_cptr vq_ = vp0 + ((s) % 3) * 16384, kq_ = kp0 + (((s) + 1) % 3) * 8192; \
          _Pragma("unroll") for (int i_ = 0; i_ < (NDB == 2 ? NPRE2 : NPRE4); ++i_) vload1(vf[i_], vq_, i_); \
          if ((s) < 64) { _Pragma("unroll") for (int i_ = 0; i_ < 8; ++i_) kf[i_] = *(const __attribute__((address_space(3))) bf16x8*)(kq_ + (i_ >> 1) * 2048 + (i_ & 1) * 512); } } while (0)
#ifndef FRAGS_FIRST_B
#define FRAGS_FIRST_B 0
#endif
#define AT_FRAGS_PART(s, lo, hi) do { const lds_cptr kq_ = kp0 + (((s) + 1) % 3) * 8192; \
          if ((s) < 64) { _Pragma("unroll") for (int i_ = (lo); i_ < (hi); ++i_) kf[i_] = *(const __attribute__((address_space(3))) bf16x8*)(kq_ + (i_ >> 1) * 2048 + (i_ & 1) * 512); } } while (0)
#ifndef FRAGS_SPLIT_B
#define FRAGS_SPLIT_B 0
#endif
#define AT_PHASE2(s) do { if (NDB == 2 || FRAGS_FIRST_B) { AT_FRAGS(s); AT_SB(); } else if (FRAGS_SPLIT_B) { AT_FRAGS_PART(s, 0, FRAGS_SPLIT_B); AT_SB(); } \
        if (PRIO_SM && (PRIO_SPLIT == 0 || NDB == 2)) __builtin_amdgcn_s_setprio(PRIO_SM); softmax_tile<!(NDB == 2 && ONES_A)>(c0, c1, l, pw); if (PRIO_SM && (PRIO_SPLIT == 0 || NDB == 2)) __builtin_amdgcn_s_setprio(0); \
        if (NDB != 2 && !FRAGS_FIRST_B) { AT_SB(); if (FRAGS_SPLIT_B) AT_FRAGS_PART(s, FRAGS_SPLIT_B, 8); else AT_FRAGS(s); } } while (0)
    if (NDB == 2) AT_WAITBAR(2); else AT_WAITBAR(3);
#pragma unroll
    for (int i_ = 0; i_ < 8; ++i_) kf[i_] = *(const __attribute__((address_space(3))) bf16x8*)(kp0 + (i_ >> 1) * 2048 + (i_ & 1) * 512);
#ifndef PRIO_STATIC
#define PRIO_STATIC 1
#endif
    if (PRIO_STATIC == 1 && wid >= 4) __builtin_amdgcn_s_setprio(1);
    if (PRIO_STATIC == 2 && wid < 4) __builtin_amdgcn_s_setprio(1);
#ifdef ATT_EPI_PROBE
    tacc[0] += __builtin_amdgcn_s_memrealtime() - pro0_;
#endif
    if (SPLIT && NDB == 4 && DMA_SPLIT_B == 2) {
        if (xrole_) {
            for (int s = 0; s < 65; ++s) { AT_PHASE1(s);
                if (s == 0) { AT_DMAS_K(1); AT_SB(); AT_WAITBAR(2); AT_SB(); } else AT_BAR_P();
                AT_PHASE2(s); AT_DMAS_K(s + 2); AT_SB(); if (s + 2 < 64) AT_WAITBAR(2); else AT_WAITBAR(0); AT_SB(); }
            AT_PHASE1(65); AT_BAR_P(); AT_BAR_P();
        } else {
            AT_DMAS_V(1); AT_SB(); AT_WAITBAR(4); AT_SB();
            for (int s = 0; s < 65; ++s) { AT_PHASE1(s); AT_BAR_P(); AT_PHASE2(s); AT_DMAS_V(s + 2); AT_SB(); if (s + 2 <= 64) AT_WAITBAR(4); else AT_WAITBAR(0); AT_SB(); }
            AT_PHASE1(65); AT_BAR_P();
        }
    } else if (SPLIT) {
        if (xrole_) {
            for (int s = 0; s < 65; ++s) { AT_PHASE1(s); AT_DMAS_K(s + 1); if (EARLY_Q && haveq && s == 63) load_q(Qnx, wid, r32, hi, qn);
                AT_SB(); if (s + 1 <= 63) AT_WAITBAR(2); else if (EARLY_Q && haveq) AT_WAITBAR(4); else AT_WAITBAR(0); AT_SB(); AT_PHASE2(s); AT_BAR_P(); }
            AT_PHASE1(65); AT_BAR_P(); AT_BAR_P();
        } else {
            AT_SB(); AT_WAITBAR(0); AT_SB();
            for (int s = 0; s < 65; ++s) { AT_PHASE1(s); AT_DMAS_V(s + 1); if (EARLY_Q && haveq && s == 64) load_q(Qnx, wid, r32, hi, qn);
                AT_SB(); if (s + 1 <= 64) { if (NDB == 2) AT_WAITBAR(2); else AT_WAITBAR(4); } else if (EARLY_Q && haveq) AT_WAITBAR(4); else AT_WAITBAR(0); AT_SB();
                AT_PHASE2(s); AT_BAR_P(); }
            AT_PHASE1(65); AT_BAR_P();
        }
    } else
    if (GRP_SEL(wid)) {
        for (int s = 0; s < 65; ++s) { TP_STAMP(t0_); AT_PHASE1(s); AT_DMA(s + 1); TP_STAMP(t1_); AT_BAR_L(s + 1); TP_STAMP(t2_); AT_PHASE2(s); TP_STAMP(t3_); AT_BAR_P(); TP_STAMP(t4_);
            if (NDB == TPROBE_NDB) { tacc[0] += t1_ - t0_; tacc[1] += t2_ - t1_; tacc[2] += t3_ - t2_; tacc[3] += t4_ - t3_; tacc[4] += 1; } }
        AT_PHASE1(65); AT_BAR_P(); AT_BAR_P();
    } else {
        AT_DMA(1); AT_BAR_L(1);
        for (int s = 0; s < 65; ++s) { TP_STAMP(t0_); AT_PHASE1(s); TP_STAMP(t1_); AT_BAR_P(); TP_STAMP(t2_); AT_PHASE2(s); AT_DMA(s + 2); TP_STAMP(t3_); AT_BAR_L(s + 2); TP_STAMP(t4_);
            if (NDB == TPROBE_NDB) { tacc[0] += t1_ - t0_; tacc[1] += t2_ - t1_; tacc[2] += t3_ - t2_; tacc[3] += t4_ - t3_; tacc[4] += 1; } }
        AT_PHASE1(65); AT_BAR_P();
    }
#undef AT_DMA
#undef AT_DMAS_K
#undef AT_DMAS_V
#undef AT_BAR_P
#undef AT_BAR_L
#undef AT_PHASE1
#undef AT_PHASE2
#undef AT_FRAGS
#undef AT_FRAGS_PART
    if (PRIO_STATIC) __builtin_amdgcn_s_setprio(0);
    l += __shfl_xor(l, 32);
    l_out = l;
}

__device__ __forceinline__ void inv_l_regs(float l, lds_ptr shm, int wid, int r32_, int hi_, float (&rli)[16]) {
    int r32 = r32_, hi = hi_; asm volatile("" : "+v"(r32), "+v"(hi));
    __attribute__((address_space(3))) float* wsf = (__attribute__((address_space(3))) float*)(shm + L_WS) + wid * 64;
    if (hi == 0) wsf[r32] = l;
    asm volatile("s_waitcnt lgkmcnt(0)" ::: "memory");
    const __attribute__((address_space(3))) float* rp = wsf + 4 * hi;
#pragma unroll
    for (int r = 0; r < 16; ++r) rli[r] = __builtin_amdgcn_rcpf(rp[(r & 3) + 8 * (r >> 2)]);
    asm volatile("s_waitcnt lgkmcnt(0)" ::: "memory");
}
template <int NDB>
__device__ __forceinline__ void store_rows(const f32x16 (&v)[NDB], lds_ptr shm, int wid, int lane_, bf16_t* dst) {
    int lane = lane_; asm volatile("" : "+v"(lane));
    const int r32 = lane & 31, hi = lane >> 5;
    __attribute__((address_space(3))) bf16_t* stg = (__attribute__((address_space(3))) bf16_t*)(shm + L_OST + wid * 8192);
    __attribute__((address_space(3))) bf16_t* wp = stg + (4 * hi) * (NDB * 32) + r32;
#pragma unroll
    for (int r = 0; r < 16; r += 2)
#pragma unroll
        for (int db = 0; db < NDB; ++db) { const unsigned w_ = cvtpk(v[db][r], v[db][r + 1]);
            wp[((r & 3) + 8 * (r >> 2)) * (NDB * 32) + db * 32] = (bf16_t)w_; wp[(((r + 1) & 3) + 8 * ((r + 1) >> 2)) * (NDB * 32) + db * 32] = (bf16_t)(w_ >> 16); }
    asm volatile("s_waitcnt lgkmcnt(0)" ::: "memory");
    constexpr int CPR = NDB * 4;
    const int row0 = lane / CPR, ch = lane % CPR;
    const __attribute__((address_space(3))) bf16_t* rp = stg + row0 * (NDB * 32) + ch * 8; bf16_t* gp = dst + (size_t)row0 * 1024 + ch * 8;
#pragma unroll
    for (int i = 0; i < (32 * CPR) / 64; ++i) {
        const u32x4 w = *(const __attribute__((address_space(3))) u32x4*)(rp + i * (64 / CPR) * (NDB * 32));
        *(u32x4*)(gp + (size_t)i * (64 / CPR) * 1024) = w; }
    asm volatile("s_waitcnt lgkmcnt(0)" ::: "memory");
}

#ifndef SUBLN_DPP
#define SUBLN_DPP 1
#endif
template <int CTRL> __device__ __forceinline__ float dppf(float v) { return __builtin_bit_cast(float, __builtin_amdgcn_update_dpp(0, __builtin_bit_cast(int, v), CTRL, 0xF, 0xF, true)); }
__device__ __forceinline__ float wave_sum_dpp(float s) { s += dppf<0xB1>(s); s += dppf<0x4E>(s); s += dppf<0x141>(s); s += dppf<0x140>(s); s += __shfl_xor(s, 16); s += __shfl_xor(s, 32); return s; }
struct Tensors { const bf16_t *QA, *QB, *KA, *VA, *KB, *VB; bf16_t* MIX; float* stash; const float *gqa, *gka, *gqb, *gkb, *lq1, *lk1, *lq2, *lk2, *subg; };

#ifdef ATT_EPI_PROBE
#define ATT_T() __builtin_amdgcn_s_memrealtime()
#else
#define ATT_T() 0ull
#endif
__device__ __forceinline__ void phase(lds_ptr shm, const Tensors& T, int vcu, int G, int lo_item, int hi_item) {
    unsigned long long att_in = 0; const unsigned long long att_p0 = ATT_T();
    const int tid = threadIdx.x, lane = tid & 63, r32 = lane & 31, hi = lane >> 5; const int wid = __builtin_amdgcn_readfirstlane(tid >> 6);
    const float McA = 0.f, McB = 0.f;
    unsigned long long tacc[5] = {0, 0, 0, 0, 0};
#ifndef ATT_ONLY
#define ATT_ONLY 3
#endif
#ifndef STASH_NT
#define STASH_NT 0
#endif
#ifndef STASH_LDS
#define STASH_LDS 1
#endif
#ifndef AB_SWAP
#define AB_SWAP 0
#endif
#define ATT_A_LOOP() do { \
    for (int item = lo_item + vcu; item < hi_item && item < 1024; item += G) { \
        if (item < 1024) { if (!(ATT_ONLY & 1)) continue; \
            const int b = (item >> 5) & 7, j = item & 31, i = item >> 8, kvh = i >> 1, idx = (i & 1) * 32 + j, h = kvh * 4 + (idx >> 4), qb = idx & 15; \
            const bf16_t* qnx_ = nullptr; \
            if (Q_PRE && EARLY_Q && DMA_SPLIT_A) { const int ni = item + G; \
                if (ni < hi_item && ni < 1024) { const int nb = (ni >> 5) & 7, nj = ni & 31, nI = ni >> 8, nidx = (nI & 1) * 32 + nj, nh = (nI >> 1) * 4 + (nidx >> 4), nqb = nidx & 15; qnx_ = T.QA + ((size_t)(nb * 8 + nh) * 4096 + nqb * 256) * 64; } \
                else if (itemB0 < hi_item) { const int wb0 = itemB0 - 1024, b0 = (wb0 >> 5) & 7, idx0 = (wb0 >> 8) * 32 + (wb0 & 31), hb0 = idx0 >> 4, qb0 = idx0 & 15; qnx_ = T.QB + ((size_t)(b0 * 8 + 2 * hb0) * 4096 + qb0 * 256) * 64; } } \
            f32x16 o[2]; float l; f32x16 ol; \
            const unsigned long long sa0_ = ATT_T(); sweep<2>(T.QA + ((size_t)(b * 8 + h) * 4096 + qb * 256) * 64, T.KA + (size_t)(b * 2 + kvh) * 65 * 4096, T.VA + (size_t)(b * 2 + kvh) * 65 * 4096, -McA, shm, o, l, tacc, ol, apre, qn, qnx_, qnx_ != nullptr); att_in += ATT_T() - sa0_; \
            if (Q_PRE && !(EARLY_Q && DMA_SPLIT_A)) { const int ni = item + G; \
                if (ni < hi_item && ni < 1024) { const int nb = (ni >> 5) & 7, nj = ni & 31, nI = ni >> 8, nidx = (nI & 1) * 32 + nj, nh = (nI >> 1) * 4 + (nidx >> 4), nqb = nidx & 15; load_q(T.QA + ((size_t)(nb * 8 + nh) * 4096 + nqb * 256) * 64, wid, r32, hi, qn); } \
                else if (itemB0 < hi_item) { const int wb0 = itemB0 - 1024, b0 = (wb0 >> 5) & 7, idx0 = (wb0 >> 8) * 32 + (wb0 & 31), hb0 = idx0 >> 4, qb0 = idx0 & 15; load_q(T.QB + ((size_t)(b0 * 8 + 2 * hb0) * 4096 + qb0 * 256) * 64, wid, r32, hi, qn); } } \
            if (PRE_ISSUE) { const int ni = item + G; apre = true; \
                if (ni < hi_item && ni < 1024) { const int nb = (ni >> 5) & 7, nkvh = ni >> 9; sweep_prefetch<2>(T.KA + (size_t)(nb * 2 + nkvh) * 65 * 4096, T.VA + (size_t)(nb * 2 + nkvh) * 65 * 4096, shm); } \
                else if (itemB0 < hi_item) { const int wb0 = itemB0 - 1024, b0 = (wb0 >> 5) & 7, idx0 = (wb0 >> 8) * 32 + (wb0 & 31), hb0 = idx0 >> 4; sweep_prefetch<4>(T.KB + (size_t)(b0 * 8 + 2 * hb0) * 65 * 4096, T.VB + (size_t)(b0 * 4 + hb0) * 65 * 8192, shm); bpre = true; } } \
            float rli[16]; if (ONES_A) { _Pragma("unroll") for (int r = 0; r < 16; ++r) rli[r] = __builtin_amdgcn_rcpf(ol[r]); } else inv_l_regs(l, shm, wid, r32, hi, rli); \
_Pragma("unroll") \
            for (int db = 0; db < 2; ++db) \
_Pragma("unroll") \
                for (int r = 0; r < 16; ++r) o[db][r] *= rli[r]; \
            store_rows<2>(o, shm, wid, lane, T.MIX + (size_t)(b * 4096 + qb * 256 + wid * 32) * 1024 + h * 64); \
        } } } while (0)
#ifndef PRE_ISSUE
#define PRE_ISSUE 1
#endif
    int itemB0 = lo_item + vcu; if (itemB0 < 1024) itemB0 += ((1024 - itemB0 + G - 1) / G) * G;
    const float lamp1 = T.lq1[lane] * T.lk1[lane], lamp2 = T.lq2[lane] * T.lk2[lane];
    bool apre = false, bpre = false;
    bf16x8 qn[4];
    if (Q_PRE) { const int it0 = lo_item + vcu;
        if (it0 < hi_item && it0 < 1024) { const int b0 = (it0 >> 5) & 7, j0 = it0 & 31, i0 = it0 >> 8, idx0 = (i0 & 1) * 32 + j0, h0 = (i0 >> 1) * 4 + (idx0 >> 4), qb0 = idx0 & 15; load_q(T.QA + ((size_t)(b0 * 8 + h0) * 4096 + qb0 * 256) * 64, wid, r32, hi, qn); }
        else if (itemB0 < hi_item) { const int wb0 = itemB0 - 1024, b0 = (wb0 >> 5) & 7, idx0 = (wb0 >> 8) * 32 + (wb0 & 31), hb0 = idx0 >> 4, qb0 = idx0 & 15; load_q(T.QB + ((size_t)(b0 * 8 + 2 * hb0) * 4096 + qb0 * 256) * 64, wid, r32, hi, qn); }
        else { _Pragma("unroll") for (int d0 = 0; d0 < 4; ++d0) qn[d0] = (bf16x8){0, 0, 0, 0, 0, 0, 0, 0}; } }
    else { _Pragma("unroll") for (int d0 = 0; d0 < 4; ++d0) qn[d0] = (bf16x8){0, 0, 0, 0, 0, 0, 0, 0}; }
    const bool swapAB = !PRE_ISSUE && AB_SWAP && ((blockIdx.x & 7) >= 4);
    if (!swapAB) ATT_A_LOOP();
    int item = lo_item + vcu; if (item < 1024) item += ((1024 - item + G - 1) / G) * G;
    const float lam = __expf(wave_sum_dpp(lamp1)) - __expf(wave_sum_dpp(lamp2)) + 0.2f;
    for (; item < hi_item; item += G) {
        { if (!(ATT_ONLY & 2)) continue;
            const int wb = item - 1024, b = (wb >> 5) & 7, j = wb & 31, i = wb >> 8, idx = i * 32 + j, hb = idx >> 4, qb = idx & 15;
            float* st = T.stash + ((size_t)(blockIdx.x * 8 + wid) * 64) * 64 + lane;
            asm volatile("" : "+v"(st));
            f32x16 o[4]; float l; float rli[16]; f32x16 olb;
            const unsigned long long sb0_ = ATT_T(); sweep<4>(T.QB + ((size_t)(b * 8 + 2 * hb) * 4096 + qb * 256) * 64, T.KB + (size_t)(b * 8 + 2 * hb) * 65 * 4096, T.VB + (size_t)(b * 4 + hb) * 65 * 8192, -McB, shm, o, l, tacc, olb, bpre, qn); att_in += ATT_T() - sb0_;
            if (Q_PRE) load_q(T.QB + ((size_t)(b * 8 + 2 * hb + 1) * 4096 + qb * 256) * 64, wid, r32, hi, qn);
            if (PRE_ISSUE) sweep_prefetch<4>(T.KB + (size_t)(b * 8 + 2 * hb + 1) * 65 * 4096, T.VB + (size_t)(b * 4 + hb) * 65 * 8192, shm);
            inv_l_regs(l, shm, wid, r32, hi, rli);
#if STASH_LDS
            { __attribute__((address_space(3))) u32x4* sl = (__attribute__((address_space(3))) u32x4*)(shm + L_OST + wid * 8192) + lane;
#pragma unroll
              for (int c = 0; c < 8; ++c) { const int db = c >> 1, r0 = (c & 1) * 8;
                  sl[c * 64] = (u32x4){cvtpk(o[db][r0] * rli[r0], o[db][r0 + 1] * rli[r0 + 1]), cvtpk(o[db][r0 + 2] * rli[r0 + 2], o[db][r0 + 3] * rli[r0 + 3]),
                                       cvtpk(o[db][r0 + 4] * rli[r0 + 4], o[db][r0 + 5] * rli[r0 + 5]), cvtpk(o[db][r0 + 6] * rli[r0 + 6], o[db][r0 + 7] * rli[r0 + 7])}; }
              asm volatile("s_waitcnt lgkmcnt(0)" ::: "memory"); }
#else
#pragma unroll
            for (int db = 0; db < 4; ++db)
#pragma unroll
                for (int r = 0; r < 16; ++r) { if (STASH_NT) __builtin_nontemporal_store(o[db][r] * rli[r], st + (db * 16 + r) * 64); else st[(db * 16 + r) * 64] = o[db][r] * rli[r]; }
#endif
            const unsigned long long sb1_ = ATT_T(); sweep<4>(T.QB + ((size_t)(b * 8 + 2 * hb + 1) * 4096 + qb * 256) * 64, T.KB + (size_t)(b * 8 + 2 * hb + 1) * 65 * 4096, T.VB + (size_t)(b * 4 + hb) * 65 * 8192, -McB, shm, o, l, tacc, olb, PRE_ISSUE != 0, qn); att_in += ATT_T() - sb1_;
            float g4_[4];
#pragma unroll
            for (int db = 0; db < 4; ++db) g4_[db] = T.subg[db * 32 + r32];
            if (Q_PRE && item + G < hi_item) { const int wbn = item + G - 1024, bn = (wbn >> 5) & 7, idxn = (wbn >> 8) * 32 + (wbn & 31), hbn = idxn >> 4, qbn = idxn & 15; load_q(T.QB + ((size_t)(bn * 8 + 2 * hbn) * 4096 + qbn * 256) * 64, wid, r32, hi, qn); }
            bpre = false;
            if (PRE_ISSUE && item + G < hi_item) { const int wbn = item + G - 1024, bn = (wbn >> 5) & 7, idxn = (wbn >> 8) * 32 + (wbn & 31), hbn = idxn >> 4; sweep_prefetch<4>(T.KB + (size_t)(bn * 8 + 2 * hbn) * 65 * 4096, T.VB + (size_t)(bn * 4 + hbn) * 65 * 8192, shm); bpre = true; }
            inv_l_regs(l, shm, wid, r32, hi, rli);
            asm volatile("" : "+v"(st));
            float ssq[16];
#pragma unroll
            for (int r = 0; r < 16; ++r) ssq[r] = 0.f;
#if STASH_LDS
            { const __attribute__((address_space(3))) u32x4* sl = (const __attribute__((address_space(3))) u32x4*)(shm + L_OST + wid * 8192) + lane;
              u32x4 sv[8];
#pragma unroll
              for (int c = 0; c < 8; ++c) sv[c] = sl[c * 64];
              asm volatile("s_waitcnt lgkmcnt(0)" ::: "memory");
#pragma unroll
              for (int c = 0; c < 8; ++c) { const int db = c >> 1, r0 = (c & 1) * 8;
#pragma unroll
                  for (int e = 0; e < 8; ++e) { const unsigned wd = sv[c][e >> 1]; const float o0 = __builtin_bit_cast(float, (e & 1) ? (wd & 0xffff0000u) : (wd << 16));
                      const float v = o0 - lam * (o[db][r0 + e] * rli[r0 + e]); o[db][r0 + e] = v; ssq[r0 + e] += v * v; } } }
#else
#pragma unroll
            for (int db = 0; db < 4; ++db)
#pragma unroll
                for (int r = 0; r < 16; ++r) { const float v = (STASH_NT ? __builtin_nontemporal_load(st + (db * 16 + r) * 64) : st[(db * 16 + r) * 64]) - lam * (o[db][r] * rli[r]); o[db][r] = v; ssq[r] += v * v; }
#endif
#if SUBLN_DPP
#pragma unroll
            for (int r = 0; r < 16; ++r) { float s = ssq[r]; s += dppf<0xB1>(s); s += dppf<0x4E>(s); s += dppf<0x141>(s); s += dppf<0x140>(s); ssq[r] = s; }
            float sx[16];
#pragma unroll
            for (int r = 0; r < 16; ++r) sx[r] = __shfl_xor(ssq[r], 16);
#pragma unroll
            for (int r = 0; r < 16; ++r) ssq[r] = __builtin_amdgcn_rsqf((ssq[r] + sx[r]) * (1.f / 128.f) + 1e-6f) * 0.8f;
#else
#pragma unroll
            for (int r = 0; r < 16; ++r) { float s = ssq[r]; s += __shfl_xor(s, 1); s += __shfl_xor(s, 2); s += __shfl_xor(s, 4); s += __shfl_xor(s, 8); s += __shfl_xor(s, 16);
                ssq[r] = __builtin_amdgcn_rsqf(s * (1.f / 128.f) + 1e-6f) * 0.8f; }
#endif
#pragma unroll
            for (int db = 0; db < 4; ++db) { const float g = g4_[db];
#pragma unroll
                for (int r = 0; r < 16; ++r) o[db][r] *= ssq[r] * g; }
            store_rows<4>(o, shm, wid, lane, T.MIX + (size_t)(b * 4096 + qb * 256 + wid * 32) * 1024 + 512 + hb * 128);
        }
    }
    if (swapAB) ATT_A_LOOP();
#ifdef ATT_EPI_PROBE
    if (blockIdx.x == 17) { const unsigned long long tot_ = ATT_T() - att_p0; const unsigned long long d_ = (ATT_EPI_SEL == 2 ? tacc[0] : ATT_EPI_SEL ? att_in : tot_ - att_in) * ATT_EPI_PROBE; const unsigned long long r0_ = ATT_T(); while (ATT_T() - r0_ < d_) __builtin_amdgcn_s_sleep(4); }
#endif
#ifdef TPROBE
    if (blockIdx.x == 17 && wid == TPROBE_WAVE && tacc[4] > 0) {
        const unsigned long long ticks = tacc[TPROBE] / tacc[4] * 10ull;
        const unsigned long long r0 = __builtin_amdgcn_s_memrealtime(); while (__builtin_amdgcn_s_memrealtime() - r0 < ticks) __builtin_amdgcn_s_sleep(4);
    }
#endif
}
}
#define GAS __attribute__((address_space(1)))
#define LAS __attribute__((address_space(3)))
typedef unsigned v4u __attribute__((ext_vector_type(4)));
typedef float f32x4 __attribute__((ext_vector_type(4)));
typedef GAS unsigned gu32;
typedef GAS unsigned long long gu64;
#define RLX_AGENT __ATOMIC_RELAXED, __HIP_MEMORY_SCOPE_AGENT
#define LDS_WAIT() asm volatile("s_waitcnt lgkmcnt(0)" ::: "memory")
#define VM_WAIT() asm volatile("s_waitcnt vmcnt(0)" ::: "memory")
__device__ __forceinline__ unsigned pk2(float lo, float hi) { return f2bf(lo) | (f2bf(hi) << 16); }
#define XB_TMO      128
#define XB_XCNT(j)  (256  + 64 * (j))
#define XB_XSUB(j)  (1280 + 64 * (j))
#define XB_XGEN(j)  (2304 + 64 * (j))
#define XB_TOP      3328
#define XB_TOPGEN   3392
#define XCD_BAR_WORDS 3456
#define XB_SPIN_CAP (1u << 18)

__device__ __forceinline__ unsigned xb_ld(unsigned* p)              { return __hip_atomic_load(p, __ATOMIC_RELAXED, __HIP_MEMORY_SCOPE_AGENT); }
__device__ __forceinline__ unsigned xb_add(unsigned* p, unsigned v) { return __hip_atomic_fetch_add(p, v, __ATOMIC_RELAXED, __HIP_MEMORY_SCOPE_AGENT); }
__device__ __forceinline__ unsigned xb_xcc_id() { return (unsigned)__builtin_amdgcn_s_getreg((3 << 11) | 20) & 0xFu; }
#define XB_SPIN(cond, bar) do { unsigned _sp = 0; while (cond) { __builtin_amdgcn_s_sleep(1); \
    if ((++_sp & 255u) == 0u) { if (xb_ld(&(bar)[XB_TMO])) break; if (_sp > XB_SPIN_CAP) { atomicAdd(&(bar)[XB_TMO], 1u); break; } } } } while (0)

struct XcdBarrier {
    unsigned* bar; unsigned x;
    volatile LAS unsigned* st;
};

__device__ __forceinline__ XcdBarrier xcd_barrier_post(unsigned* bar, volatile LAS unsigned* st) {
    XcdBarrier b; b.bar = bar; b.x = xb_xcc_id(); b.st = st;
    if (threadIdx.x == 0) (void)xb_add(&bar[XB_XCNT(b.x)], 1u);
    return b;
}
__device__ __forceinline__ void xcd_barrier_complete(unsigned* bar, unsigned x, unsigned& nloc, unsigned& nx) {
    const unsigned G = gridDim.x * gridDim.y * gridDim.z;
    unsigned sum, cnt, mine, sp = 0u;
    for (;;) {
        sum = 0u; cnt = 0u; mine = 0u;
#pragma unroll
        for (unsigned j = 0; j < 16; ++j) { const unsigned c = xb_ld(&bar[XB_XCNT(j)]); sum += c; cnt += (c > 0u) ? 1u : 0u; mine = (j == x) ? c : mine; }
        if (sum == G) break;
        __builtin_amdgcn_s_sleep(1);
        if ((++sp & 255u) == 0u) { if (xb_ld(&bar[XB_TMO])) break; if (sp > XB_SPIN_CAP) { atomicAdd(&bar[XB_TMO], 1u); break; } }
    }
    nloc = mine > 0u ? mine : 1u; nx = cnt > 0u ? cnt : 1u;
}

#ifndef BAR_POLL_TOP
#define BAR_POLL_TOP 0
#endif
__device__ __forceinline__ void xcd_barrier(const XcdBarrier& b) {
    asm volatile("s_waitcnt vmcnt(0)" ::: "memory");
    __syncthreads();
    if (threadIdx.x == 0) {
        unsigned* bar = b.bar;
        __builtin_amdgcn_s_waitcnt(0);
        unsigned nloc = b.st[0], nx = b.st[1];
        if (nloc == 0u) { xcd_barrier_complete(bar, b.x, nloc, nx); b.st[0] = nloc; b.st[1] = nx; }
        const unsigned old = xb_add(&bar[XB_XSUB(b.x)], 1u);
        const unsigned gen = old / nloc;
        if (old + 1u == (gen + 1u) * nloc) {
#ifdef WBL2_PROBE
            const unsigned long long w0_ = __builtin_amdgcn_s_memrealtime();
#endif
            __builtin_amdgcn_fence(__ATOMIC_RELEASE, "agent");
            asm volatile("s_waitcnt vmcnt(0)" ::: "memory");
#ifdef WBL2_PROBE
            b.st[2] = b.st[2] + (unsigned)(__builtin_amdgcn_s_memrealtime() - w0_);
#endif
            const unsigned og = xb_add(&bar[XB_TOP], 1u);
            const unsigned tg = og / nx;
            if (og + 1u == (tg + 1u) * nx) xb_add(&bar[XB_TOPGEN], 1u);
            else XB_SPIN(xb_ld(&bar[XB_TOPGEN]) == tg, bar);
            __builtin_amdgcn_fence(__ATOMIC_ACQUIRE, "agent");
            xb_add(&bar[XB_XGEN(b.x)], 1u);
            asm volatile("s_waitcnt vmcnt(0)" ::: "memory");
        } else {
#if BAR_POLL_TOP
            XB_SPIN(xb_ld(&bar[XB_TOPGEN]) <= gen, bar);
#else
            XB_SPIN(xb_ld(&bar[XB_XGEN(b.x)]) == gen, bar);
#endif
            __builtin_amdgcn_fence(__ATOMIC_ACQUIRE, "agent");
            asm volatile("s_waitcnt vmcnt(0)" ::: "memory");
        }
    }
    __syncthreads();
}

#define XB_LG(g) (3520 + 64 * (g))
__device__ __forceinline__ void group_barrier(const XcdBarrier& b, unsigned g, unsigned target) {
    asm volatile("s_waitcnt vmcnt(0)" ::: "memory");
    __syncthreads();
    if (threadIdx.x == 0) {
        unsigned* bar = b.bar;
        __builtin_amdgcn_s_waitcnt(0);
        __builtin_amdgcn_fence(__ATOMIC_RELEASE, "agent");
        asm volatile("s_waitcnt vmcnt(0)" ::: "memory");
        (void)xb_add(&bar[XB_LG(g)], 1u);
        XB_SPIN(xb_ld(&bar[XB_LG(g)]) < target, bar);
        __builtin_amdgcn_fence(__ATOMIC_ACQUIRE, "agent");
        asm volatile("s_waitcnt vmcnt(0)" ::: "memory");
    }
    __syncthreads();
}
constexpr int NWAVES = 8;
#ifndef PG_SP2
#define PG_SP2 true
#endif
#ifndef P1_ALIGN
#define P1_ALIGN true
#endif
#ifndef P35_ALIGN
#define P35_ALIGN true
#endif
#ifndef P4_ALIGN
#define P4_ALIGN true
#endif
constexpr int RING_OFF = 0, RING_BYTES = 159744, LDSCTL_OFF = RING_BYTES, MISC_OFF = LDSCTL_OFF + 320, LDS_BYTES = 163840;
static_assert(att::L_END <= RING_BYTES, "attention LDS map");
constexpr int CW_BAR = 4096;
constexpr size_t CTL_ZERO_BYTES = 64 * 1024;
static_assert(WS_TA + 4097ull * 256 <= WS_TB && WS_TB + 4112ull * 256 <= WS_BT1 && WS_BT1 + 2304ull * 2048 <= WS_BT3 && WS_BT3 + 1024ull * 2048 <= WS_BT4 && WS_BT4 + 5632ull * 2048 <= WS_BT5 && WS_BT5 + 1024ull * 5632 <= WS_XB, "ws map 2");
static_assert(WS_STASH + 256ull * 8 * 64 * 64 * 4 <= WS_END, "stash");

struct Args { const float* in[18]; float* out; unsigned char* ws; RopeInv inv; int ph_lo, ph_hi; unsigned char p1tab[256]; };
static_assert(sizeof(Args) == 18 * 8 + 8 + 8 + 192 + 8 + 256, "Args has no padding");

__device__ __forceinline__ float wave_sum_f(float v) {
#pragma unroll
    for (int o = 1; o < 64; o <<= 1) v += __shfl_xor(v, o);
    return v;
}
#ifndef W_NTLOAD
#define W_NTLOAD 1
#endif
struct TItem { const float* W; bf16_t* WT; const float* gain; int K, N, drow0, k0, n0; };
__device__ __forceinline__ void titem_load(const TItem& t, int lane, f32x4 (&v)[8], float (&g)[8]) {
#pragma unroll
    for (int i = 0; i < 8; ++i) { const int kk = (lane >> 3) + 8 * i;
        const f32x4* wp_ = (const f32x4*)(t.W + (size_t)(t.k0 + kk) * t.N + t.n0 + 4 * (lane & 7)); v[i] = W_NTLOAD ? __builtin_nontemporal_load(wp_) : *wp_; g[i] = t.gain ? t.gain[t.k0 + kk] : 1.f; }
}
__device__ __forceinline__ void titem_finish(const TItem& t, int lane, const f32x4 (&v)[8], const float (&g)[8], LAS float* scr) {
#pragma unroll
    for (int i = 0; i < 8; ++i) { const int kk = (lane >> 3) + 8 * i; *(LAS f32x4*)(scr + kk * 36 + 4 * (lane & 7)) = v[i] * g[i]; }
    LDS_WAIT(); asm volatile("" ::: "memory");
    const int c = lane & 7;
#pragma unroll
    for (int j = 0; j < 4; ++j) { const int n = (lane >> 3) + 8 * j; const LAS float* s = scr + (8 * c) * 36 + n;
        v4u o; o.x = pk2(s[0 * 36], s[1 * 36]); o.y = pk2(s[2 * 36], s[3 * 36]); o.z = pk2(s[4 * 36], s[5 * 36]); o.w = pk2(s[6 * 36], s[7 * 36]);
        *(GAS v4u*)(t.WT + (size_t)(t.drow0 + n) * t.K + t.k0 + 8 * c) = o; }
    LDS_WAIT(); asm volatile("" ::: "memory");
}

#ifdef P0_SUB_PROBE
#define P0_TS(k) do { asm volatile("s_waitcnt vmcnt(0) lgkmcnt(0)" ::: "memory"); p0ts[k] = __builtin_amdgcn_s_memrealtime(); } while (0)
#else
#define P0_TS(k) do {} while (0)
#endif
__device__ __forceinline__ void p0_prologue(const Args& A, LAS unsigned char* lds, int vcu, int G, int wave, int lane, unsigned long long (&p0ts)[6]) {
    P0_TS(0);
    const float* x = A.in[0]; const float* meta = A.in[1]; const float* g1 = A.in[2]; const float* w_in = A.in[3]; const float* w_out = A.in[13]; const float* g2 = A.in[14];
    const float* w_gate = A.in[15]; const float* w_up = A.in[16]; const float* w_down = A.in[17];
    unsigned char* ws = A.ws;
    bf16_t *Bt1 = (bf16_t*)(ws + WS_BT1), *Bt3 = (bf16_t*)(ws + WS_BT3), *Bt4 = (bf16_t*)(ws + WS_BT4), *Bt5 = (bf16_t*)(ws + WS_BT5), *XB = (bf16_t*)(ws + WS_XB);
    float *ss = (float*)(ws + WS_RS), *ss2 = (float*)(ws + WS_SS), *TA = (float*)(ws + WS_TA), *TB = (float*)(ws + WS_TB);
    LAS float* scr = (LAS float*)(lds + RING_OFF + wave * 16384);
    const int gw = vcu * NWAVES + wave, NGW = G * NWAVES;
    constexpr int I_IN = 16 * 72;
    for (int it = gw; it < I_IN; it += NGW) { const int kb = it / 72, nb = it % 72, c0 = nb * 32; const TItem t{w_in, Bt1, g1, 1024, 2304, (c0 & ~255) + 128 * ((c0 & 63) >> 5) + 32 * ((c0 & 255) >> 6), 64 * kb, c0};
        f32x4 v[8]; float g[8]; titem_load(t, lane, v, g); titem_finish(t, lane, v, g, scr); }
    P0_TS(1);
#ifndef P0_NTLOAD
#define P0_NTLOAD 1
#endif
#ifndef P0_CONTIG
#define P0_CONTIG 1
#endif
#ifndef P0_RPS
#define P0_RPS 4
#endif
#define P0_ROW(s, q) (cb < 2048 ? cb * 16 + (s) * P0_RPS + (q) : ((q) == 0 ? 32768 + (cb - 2048) : 33024))
    for (int cb = gw; cb < 2048 + 256; cb += NGW)
    for (int st = 0; st < (cb < 2048 ? 16 / P0_RPS : 1); ++st) {
        f32x4 v[P0_RPS][4];
#pragma unroll
        for (int q = 0; q < P0_RPS; ++q) { const int m = P0_ROW(st, q);
            if (m < NTOK + NMETA) { const GAS f32x4* xr = (const GAS f32x4*)(m < NTOK ? x + (size_t)m * 1024 : meta + (size_t)(m - NTOK) * 1024) + lane;
#pragma unroll
                for (int j = 0; j < 4; ++j) v[q][j] = P0_NTLOAD ? __builtin_nontemporal_load((const f32x4*)(xr + 64 * j)) : xr[64 * j]; }
            else {
#pragma unroll
                for (int j = 0; j < 4; ++j) v[q][j] = (f32x4){0.f, 0.f, 0.f, 0.f}; } }
#pragma unroll
        for (int q = 0; q < P0_RPS; ++q) { const int m = P0_ROW(st, q);
            if (m < 33024) {
                float s = 0.f;
#pragma unroll
                for (int j = 0; j < 4; ++j) s += (v[q][j].x * v[q][j].x + v[q][j].y * v[q][j].y) + (v[q][j].z * v[q][j].z + v[q][j].w * v[q][j].w);
                s = wave_sum_f(s);
                GAS unsigned long long* o8 = (GAS unsigned long long*)(XB + (size_t)m * 1024) + lane;
#pragma unroll
                for (int j = 0; j < 4; ++j) o8[64 * j] = (unsigned long long)pk2(v[q][j].x, v[q][j].y) | ((unsigned long long)pk2(v[q][j].z, v[q][j].w) << 32);
                if (lane == 0) ss[m] = m < NTOK + NMETA ? s : 1024.f;
            } }
    }
    P0_TS(2);
    const int gt = gw * 64 + lane, NGT = NGW * 64;
    for (int e = gt; e < (4097 + 4112) * 32; e += NGT) {
        const int p = e >> 5, i = e & 31; const bool isA = p < 4097; const int pos = isA ? p : p - 4097; float* dst = (isA ? TA : TB) + (size_t)pos * 64;
        float ang;
        if (isA) ang = pos == 4096 ? 0.f : (i < 16 ? (float)(pos >> 6) * A.inv.a[i] : (float)(pos & 63) * A.inv.a[i - 16]);
        else ang = (float)pos * A.inv.b[i];
        float c, s2; rope_cs(ang, c, s2); *(float2*)(dst + 2 * i) = make_float2(c, s2);
    }
    P0_TS(3);
    if (gw < 4) ((float*)(ws + WS_GT))[gw * 64 + lane] = A.in[4 + gw][lane];
    for (int i = gt; i < NTOK; i += NGT) ss2[i] = 0.f;
    {   bf16_t *KA = (bf16_t*)(ws + WS_KA), *VA = (bf16_t*)(ws + WS_VA), *KB = (bf16_t*)(ws + WS_KB), *VB = (bf16_t*)(ws + WS_VB);
        const v4u z = (v4u){0u, 0u, 0u, 0u};
        for (int i = gt; i < (16 + 64) * 384; i += NGT) { const int g = i / 384, e = i % 384, c = e / 48, k = 16 + e % 48;
            bf16_t* base = g < 16 ? KA + (size_t)g * 65 * 4096 : KB + (size_t)(g - 16) * 65 * 4096; *(GAS v4u*)(base + c * 512 + k * 8) = z; }
        for (int i = gt; i < 16 * 2 * 192 + 32 * 4 * 192; i += NGT) {
            if (i < 16 * 2 * 192) { const int g = i / 384, e = i % 384, db = e / 192, q = e % 192; *(GAS v4u*)(VA + (size_t)g * 65 * 4096 + db * 2048 + 16 * 32 + q * 8) = z; }
            else { const int i2 = i - 16 * 2 * 192, g = i2 / 768, e = i2 % 768, db = e / 192, q = e % 192; *(GAS v4u*)(VB + (size_t)g * 65 * 8192 + db * 2048 + 16 * 32 + q * 8) = z; }
        }
    }
}

__device__ __forceinline__ void p1_late_weights(const Args& A, LAS unsigned char* lds, int widx, int nw, int wave, int lane) {
    const float* w_out = A.in[13]; const float* g2 = A.in[14]; const float* w_gate = A.in[15]; const float* w_up = A.in[16]; const float* w_down = A.in[17];
    unsigned char* ws = A.ws;
    bf16_t *Bt3 = (bf16_t*)(ws + WS_BT3), *Bt4 = (bf16_t*)(ws + WS_BT4), *Bt5 = (bf16_t*)(ws + WS_BT5);
    LAS float* scr = (LAS float*)(lds + RING_OFF + wave * 16384);
    constexpr int I_OUT = 16 * 32, I_G = 16 * 88, I_D = 44 * 32, NITEMS = I_OUT + 2 * I_G + I_D;
    auto decode = [&](int it, TItem& t) {
        int r = it;
        if (r < I_OUT) { const int kb = r / 32, nb = r % 32; t = TItem{w_out, Bt3, nullptr, 1024, 1024, nb * 32, 64 * kb, nb * 32}; return; } r -= I_OUT;
        if (r < I_G) { const int kb = r / 88, nb = r % 88, f0 = nb * 32; t = TItem{w_gate, Bt4, g2, 1024, 2816, 256 * (f0 >> 7) + (f0 & 127), 64 * kb, f0}; return; } r -= I_G;
        if (r < I_G) { const int kb = r / 88, nb = r % 88, f0 = nb * 32; t = TItem{w_up, Bt4, g2, 1024, 2816, 256 * (f0 >> 7) + 128 + (f0 & 127), 64 * kb, f0}; return; } r -= I_G;
        { const int kb = r / 32, nb = r % 32; t = TItem{w_down, Bt5, nullptr, 2816, 1024, nb * 32, 64 * kb, nb * 32}; }
    };
    int it = widx; if (it >= NITEMS) return;
    TItem cur, nxt; f32x4 va[8], vb[8]; float ga[8], gb[8];
    decode(it, cur); titem_load(cur, lane, va, ga);
    for (;;) {
        const int itn = it + nw; const bool hn = itn < NITEMS;
        if (hn) { decode(itn, nxt); titem_load(nxt, lane, vb, gb); }
        titem_finish(cur, lane, va, ga, scr);
        if (!hn) break;
        cur = nxt; it = itn;
#pragma unroll
        for (int i = 0; i < 8; ++i) { va[i] = vb[i]; ga[i] = gb[i]; }
    }
}

__global__ void __launch_bounds__(NWAVES * 64, 2) mega_fwd(Args args) {
    extern __shared__ __attribute__((aligned(16))) unsigned char lds_raw[];
    LAS unsigned char* lds = (LAS unsigned char*)lds_raw;
    volatile LAS unsigned* MISC = (volatile LAS unsigned*)(lds + MISC_OFF);
    const int tid = threadIdx.x, lane = tid & 63, wave = __builtin_amdgcn_readfirstlane(tid >> 6);
    const int G = gridDim.x; const int bx = blockIdx.x; const int vcu = (G % 8 == 0) ? (bx % 8) * (G / 8) + bx / 8 : bx;
    unsigned char* ws = args.ws;
    gu32* ctl = (gu32*)(ws + WS_CTL);
    for (int u = tid; u < (LDS_BYTES - LDSCTL_OFF) / 4; u += NWAVES * 64) ((LAS unsigned*)(lds + LDSCTL_OFF))[u] = 0u;
    __syncthreads();
    const int lo = args.ph_lo, hi = args.ph_hi;
    const bool multi = hi - lo > 1;
    XcdBarrier bar; bar.bar = (unsigned*)(ctl + CW_BAR); bar.x = 0; bar.st = nullptr;
    if (multi) bar = xcd_barrier_post((unsigned*)(ctl + CW_BAR), MISC + 8);
#ifndef P1_WGM
#define P1_WGM 8
#endif
#ifndef STAG_N
#define STAG_N 8
#endif
#ifndef STAG_SEL
#define STAG_SEL ((bx >> 3) & (STAG_N - 1))
#endif
#ifndef PH_MASK
#define PH_MASK 63
#endif
#define IN(k) (((PH_MASK >> (k)) & 1) && lo <= (k) && (k) < hi)
#ifdef SEAM_PROBE
#ifndef PHASE_PROBE
#define PHASE_PROBE 99
#endif
    unsigned long long seam_acc = 0, ph_t0 = (PHASE_PROBE == 0) ? __builtin_amdgcn_s_memrealtime() : 0ull;
#ifndef PHASE_PROBE
#define PHASE_PROBE 99
#endif
#define SEAM(k) do { if (IN(k) && IN((k) + 1)) { const unsigned long long q0_ = __builtin_amdgcn_s_memrealtime(); if ((k) == PHASE_PROBE) seam_acc += q0_ - ph_t0; xcd_barrier(bar); const unsigned long long q1_ = __builtin_amdgcn_s_memrealtime(); if ((SEAM_PROBE >> (k)) & 1) seam_acc += q1_ - q0_; if ((k) + 1 == PHASE_PROBE) ph_t0 = q1_; } } while (0)
#else
#define SEAM(k) do { if (IN(k) && IN((k) + 1)) xcd_barrier(bar); } while (0)
#endif
#ifndef LOCAL_SEAMS
#define LOCAL_SEAMS 0
#endif
    const bool local_seams = LOCAL_SEAMS && multi && G == 256 && lo <= 2 && hi >= 6;
#define SEAM_L(k) do { if (IN(k) && IN((k) + 1)) { if (local_seams) group_barrier(bar, (unsigned)(bx & 7), (unsigned)(G >> 3) * ((k) / 2)); else xcd_barrier(bar); } } while (0)
    bf16_t *Bt1 = (bf16_t*)(ws + WS_BT1), *Bt3 = (bf16_t*)(ws + WS_BT3), *Bt4 = (bf16_t*)(ws + WS_BT4), *Bt5 = (bf16_t*)(ws + WS_BT5), *XB = (bf16_t*)(ws + WS_XB);
    bf16_t *QA = (bf16_t*)(ws + WS_QA), *QB = (bf16_t*)(ws + WS_QB), *KA = (bf16_t*)(ws + WS_KA), *VA = (bf16_t*)(ws + WS_VA), *KB = (bf16_t*)(ws + WS_KB), *VB = (bf16_t*)(ws + WS_VB);
    bf16_t *MIX = (bf16_t*)(ws + WS_MIX), *X1B = (bf16_t*)(ws + WS_X1B), *HID = (bf16_t*)(ws + WS_HID);
    float *ss = (float*)(ws + WS_RS), *ss2 = (float*)(ws + WS_SS), *TA = (float*)(ws + WS_TA), *TB = (float*)(ws + WS_TB);

    unsigned long long p0ts[6] = {0, 0, 0, 0, 0, 0}; unsigned long long epi_time = 0;
    if (IN(0)) { p0_prologue(args, lds, vcu, G, wave, lane, p0ts); P0_TS(4); SEAM(0); }
    if (IN(1)) {
        pg8::Gemm g{XB, Bt1, 33024, 2304, 1024}; pg8::P1Order S; S.init(33024, 2304, G, bx, P1_WGM); S.t5 = (G == 256) ? (int)args.p1tab[bx] : (bx < (129 * 9) % 256 ? bx : 137 + bx);
        S.remap = (G == 256);
        pg8::EpiProj E{ss, (const float*)(ws + WS_GT), TA, (bf16_t*)ws};
#ifndef STAG1
#define STAG1 0
#endif
#ifndef STAG1B
#define STAG1B 0
#endif
#if STAG1 || STAG1B
        { const int rem_ = (129 * 9) % G; const unsigned long long r0_ = __builtin_amdgcn_s_memrealtime();
          const unsigned long long d_ = (rem_ != 0 && bx >= rem_) ? (unsigned long long)((bx - rem_) % 16) * STAG1 : (unsigned long long)((bx >> 3) & 7) * STAG1B;
          while (__builtin_amdgcn_s_memrealtime() - r0_ < d_) __builtin_amdgcn_s_sleep(1); }
#endif
#if defined(EPI_TIME_PROBE) && EPI_TIME_PHASE == 1
        pg8::gemm_phase<pg8::EpiProj, pg8::P1Order, P1_ALIGN, PG_SP2>(lds + RING_OFF, g, S, E, &epi_time);
#else
        pg8::gemm_phase<pg8::EpiProj, pg8::P1Order, P1_ALIGN, PG_SP2>(lds + RING_OFF, g, S, E);
#endif
        if (G == 256) { const int t5 = (int)args.p1tab[bx];
          if (t5 >= 137) p1_late_weights(args, lds, (t5 - 137) * NWAVES + wave, (256 - 137) * NWAVES, wave, lane); }
        else { const int rem = (129 * 9) % G, first_idle = rem;
          if (bx >= first_idle) p1_late_weights(args, lds, (bx - first_idle) * NWAVES + wave, (G - first_idle) * NWAVES, wave, lane); }
        SEAM(1);
    }
    if (IN(2) || lo == 6 || lo == 7) {
        att::Tensors T{QA, QB, KA, VA, KB, VB, MIX, (float*)(ws + WS_STASH), args.in[4], args.in[5], args.in[6], args.in[7], args.in[8], args.in[9], args.in[10], args.in[11], args.in[12]};
#ifdef CLOCK_PROBE
        const unsigned long long t0_ = __builtin_amdgcn_s_memtime(), r0_ = __builtin_amdgcn_s_memrealtime();
#endif
        att::phase((att::lds_ptr)(lds + RING_OFF), T, vcu, G, lo == 7 ? 1024 : 0, hi == 7 && lo == 6 ? 1024 : 1536);
#ifdef CLOCK_PROBE
        { const unsigned long long t1_ = __builtin_amdgcn_s_memtime(), r1_ = __builtin_amdgcn_s_memrealtime();
          if (bx == 17 && tid == 0) { float* pr = (float*)(ws + WS_GT + 4096); pr[0] = (float)(t1_ - t0_) / (float)(r1_ - r0_) * 100.f; pr[1] = (float)(r1_ - r0_) * 0.01f; } }
#endif
        SEAM_L(2);
    }
    if (IN(3) || lo == 8) {
        pg8::Gemm g{MIX, Bt3, 32768, 1024, 1024}; pg8::StaticOrder S; S.init(32768, 1024, G, bx);
        pg8::EpiRes1 E{args.in[0], args.out, X1B, lo == 8 ? (float*)(ws + WS_STASH) : ss2, XB};
#ifndef STAG3
#define STAG3 0
#endif
#if STAG3
        { const unsigned long long r0_ = __builtin_amdgcn_s_memrealtime(); const unsigned long long d_ = (unsigned long long)(STAG_SEL) * STAG3;
          while (__builtin_amdgcn_s_memrealtime() - r0_ < d_) __builtin_amdgcn_s_sleep(1); }
#endif
#if defined(EPI_TIME_PROBE) && EPI_TIME_PHASE == 3
        pg8::gemm_phase<pg8::EpiRes1, pg8::StaticOrder, P35_ALIGN, PG_SP2>(lds + RING_OFF, g, S, E, &epi_time);
#else
        pg8::gemm_phase<pg8::EpiRes1, pg8::StaticOrder, P35_ALIGN, PG_SP2>(lds + RING_OFF, g, S, E);
#endif
        SEAM(3);
#ifdef XBAR_PROBE
        for (int i_ = 0; i_ < XBAR_PROBE; ++i_) xcd_barrier(bar);
#endif
    }
    if (IN(4)) {
        pg8::Gemm g{X1B, Bt4, 32768, 5632, 1024}; pg8::StaticOrder S; S.init(32768, 5632, G, bx);
        pg8::EpiSwiglu E{ss2, HID};
#ifndef STAG4
#define STAG4 0
#endif
#if STAG4
        { const unsigned long long r0_ = __builtin_amdgcn_s_memrealtime(); const unsigned long long d_ = (unsigned long long)(STAG_SEL) * STAG4;
          while (__builtin_amdgcn_s_memrealtime() - r0_ < d_) __builtin_amdgcn_s_sleep(1); }
#endif
#if defined(EPI_TIME_PROBE) && EPI_TIME_PHASE == 4
        pg8::gemm_phase<pg8::EpiSwiglu, pg8::StaticOrder, P4_ALIGN, PG_SP2>(lds + RING_OFF, g, S, E, &epi_time);
#else
        pg8::gemm_phase<pg8::EpiSwiglu, pg8::StaticOrder, P4_ALIGN, PG_SP2>(lds + RING_OFF, g, S, E);
#endif
        SEAM_L(4);
    }
    if (IN(5)) {
        pg8::Gemm g{HID, Bt5, 32768, 1024, 2816}; pg8::StaticOrder S; S.init(32768, 1024, G, bx);
        pg8::EpiRes2 E{args.out, X1B};
#ifndef STAG5
#define STAG5 0
#endif
#if STAG5
        { const unsigned long long r0_ = __builtin_amdgcn_s_memrealtime(); const unsigned long long d_ = (unsigned long long)(STAG_SEL) * STAG5;
          while (__builtin_amdgcn_s_memrealtime() - r0_ < d_) __builtin_amdgcn_s_sleep(1); }
#endif
#if defined(EPI_TIME_PROBE) && EPI_TIME_PHASE == 5
        pg8::gemm_phase<pg8::EpiRes2, pg8::StaticOrder, P35_ALIGN, PG_SP2>(lds + RING_OFF, g, S, E, &epi_time);
#else
        pg8::gemm_phase<pg8::EpiRes2, pg8::StaticOrder, P35_ALIGN, PG_SP2>(lds + RING_OFF, g, S, E);
#endif
    }
#ifdef WBL2_PROBE
    { const unsigned long long r0_ = __builtin_amdgcn_s_memrealtime(); const unsigned long long d_ = (unsigned long long)MISC[10] * WBL2_PROBE; while (__builtin_amdgcn_s_memrealtime() - r0_ < d_) __builtin_amdgcn_s_sleep(4); }
#endif
#ifdef PHASE_MAX_PROBE
    if (PHASE_MAX_SEL) { const unsigned long long r0_ = __builtin_amdgcn_s_memrealtime(); const unsigned long long d_ = seam_acc > PHASE_MAX_BASE ? (seam_acc - PHASE_MAX_BASE) * PHASE_MAX_PROBE : 0ull; while (__builtin_amdgcn_s_memrealtime() - r0_ < d_) __builtin_amdgcn_s_sleep(4); }
#endif
#ifdef P0_SUB_PROBE
    { const unsigned long long r0_ = __builtin_amdgcn_s_memrealtime(); const unsigned long long d_ = (p0ts[P0_SUB_PROBE] - p0ts[P0_SUB_PROBE - 1]) * 10ull; while (__builtin_amdgcn_s_memrealtime() - r0_ < d_) __builtin_amdgcn_s_sleep(4); }
#endif
#ifdef EPI_TIME_PROBE
    if (bx == EPI_TIME_BX) { const unsigned long long r0_ = __builtin_amdgcn_s_memrealtime(); while (__builtin_amdgcn_s_memrealtime() - r0_ < epi_time * EPI_TIME_PROBE) __builtin_amdgcn_s_sleep(4); }
#endif
#ifdef SEAM_PROBE
    if (bx == SEAM_PROBE_BX) { const unsigned long long r0_ = __builtin_amdgcn_s_memrealtime(); while (__builtin_amdgcn_s_memrealtime() - r0_ < seam_acc * SEAM_PROBE_MULT) __builtin_amdgcn_s_sleep(4); }
#endif
#undef IN
#undef SEAM
}
extern "C" void kernel_launch(void* const* d_in, const int* in_sizes, int n_in, void* d_out, int out_size, void* d_ws, size_t ws_size, hipStream_t stream) {
    float* out = (float*)d_out; unsigned char* ws = (unsigned char*)d_ws;
    if (n_in != 18 || ws_size < WS_END || out_size != NTOK * DM || in_sizes[0] != NTOK * DM) { fprintf(stderr, "kernel_launch: unexpected shapes (n_in %d, ws %zu, out %d)\n", n_in, ws_size, out_size); return; }
    RopeInv inv;
    for (int i = 0; i < 16; ++i) inv.a[i] = (float)pow(10000.0, -(double)(2 * i) / 32.0);
    for (int i = 0; i < 32; ++i) inv.b[i] = (float)pow(10000.0, -(double)(2 * i) / 64.0);
    static int grid = 0;
    if (grid == 0) {
        int dev = 0, cus = 0, per_cu = 0;
        if (hipGetDevice(&dev) != hipSuccess || hipDeviceGetAttribute(&cus, hipDeviceAttributeMultiprocessorCount, dev) != hipSuccess) { fprintf(stderr, "kernel_launch: device query failed\n"); grid = -1; return; }
        if (hipFuncSetAttribute((const void*)mega_fwd, hipFuncAttributeMaxDynamicSharedMemorySize, LDS_BYTES) != hipSuccess) { fprintf(stderr, "kernel_launch: hipFuncSetAttribute failed\n"); grid = -1; return; }
        if (hipOccupancyMaxActiveBlocksPerMultiprocessor(&per_cu, (const void*)mega_fwd, NWAVES * 64, LDS_BYTES) != hipSuccess || per_cu < 1) { fprintf(stderr, "kernel_launch: the occupancy query reports %d workgroups per CU for %d B of LDS; nothing launched\n", per_cu, LDS_BYTES); (void)hipGetLastError(); grid = -1; return; }
        (void)hipGetLastError();
        grid = cus;
    }
    if (grid < 0) return;
    Args a{};
    for (int i = 0; i < 18; ++i) a.in[i] = (const float*)d_in[i];
    a.out = out; a.ws = ws; a.inv = inv; a.ph_lo = 0; a.ph_hi = 6;
    {
        static unsigned char tab[256]; static bool have = false;
        if (!have) {
            const float cst[9] = {8.5f, 8.5f, 10.1f, 8.5f, 8.5f, 10.1f, 10.1f, 4.7f, 4.7f};
            pg8::StaticOrder so; float s4[256], c5[137]; int ord[256], tl[137];
            for (int c = 0; c < 256; ++c) { so.init(33024, 2304, 256, c); s4[c] = 0.f; for (int i = 0; i < 4; ++i) { pg8::Unit u; so.next(i, u); s4[c] += u.pm == 128 ? 3.f : cst[u.pn]; } ord[c] = c; }
            for (int r = 0; r < 137; ++r) { so.init(33024, 2304, 256, r); pg8::Unit u; so.next(4, u); c5[r] = u.pm == 128 ? 3.f : cst[u.pn]; tl[r] = r; }
            for (int i = 1; i < 256; ++i) { const int v = ord[i]; int j = i - 1; while (j >= 0 && s4[ord[j]] > s4[v]) { ord[j + 1] = ord[j]; --j; } ord[j + 1] = v; }
            for (int i = 1; i < 137; ++i) { const int v = tl[i]; int j = i - 1; while (j >= 0 && c5[tl[j]] < c5[v]) { tl[j + 1] = tl[j]; --j; } tl[j + 1] = v; }
            for (int i = 0; i < 137; ++i) tab[ord[i]] = (unsigned char)tl[i];
            for (int i = 137; i < 256; ++i) tab[ord[i]] = (unsigned char)(137 + (i - 137));
            have = true;
        }
        for (int c = 0; c < 256; ++c) a.p1tab[c] = tab[c];
    }
    (void)hipMemsetAsync(ws + WS_CTL, 0, CTL_ZERO_BYTES, stream);
    hipLaunchKernelGGL(mega_fwd, dim3(grid), dim3(NWAVES * 64), LDS_BYTES, stream, a);
}
```
